# Optimizing an MI355X kernel written in HIP

```python
import math
import jax, jax.numpy as jnp
from jax import lax
import numpy as np

D_MODEL = 1024
BATCH = 8
SEQ = 4096
DEPTH = 2

N_A_LAYERS = DEPTH // 2
N_B_LAYERS = DEPTH - N_A_LAYERS
PLE_DIM = 256
NORM_EPS = 1e-6
GATED_NORM_EPS = 1e-5
SSM_EXPAND = 2
D_INNER = SSM_EXPAND * D_MODEL
SSM_HEADDIM = 64
SSM_HEADS = D_INNER // SSM_HEADDIM
SSM_GROUPS = 8
SSM_HPG = SSM_HEADS // SSM_GROUPS
SSM_STATE = 128
CONV_K = 4
CONV_DIM = D_INNER + 2 * SSM_GROUPS * SSM_STATE
D_IN_PROJ = D_INNER + CONV_DIM + SSM_HEADS
SSD_CHUNK = 128
HEAD_DIM = 64
N_Q_HEADS = D_MODEL // HEAD_DIM
N_KV_HEADS = 2
Q_PER_KV = N_Q_HEADS // N_KV_HEADS
WINDOW = 128
ROT_DIM = HEAD_DIM // 4
ROPE_THETA = 500000.0
KV_DIM = N_KV_HEADS * HEAD_DIM
PEER_HEADS = 8
N_KEYS = 128
N_EXPERTS = N_KEYS * N_KEYS
PEER_DK = 256
PEER_HALF = PEER_DK // 2
PEER_TOPK = 16
PEER_BLOCK = 128

kernel_name = 'hybrid_ssd_swa_sink_peer_yoco'


def rmsnorm(x, g, eps=NORM_EPS):
    xf = x.astype(jnp.float32)
    xf = xf * lax.rsqrt(jnp.mean(xf * xf, axis=-1, keepdims=True) + eps)
    return (xf * g.astype(jnp.float32)).astype(x.dtype)


def rope_tables(positions):
    inv = jnp.power(ROPE_THETA, -jnp.arange(0, ROT_DIM, 2, dtype=jnp.float32) / ROT_DIM)
    ang = positions.astype(jnp.float32)[..., None] * inv
    return jnp.cos(ang)[:, :, None, :], jnp.sin(ang)[:, :, None, :]


def apply_partial_rope(t, cos, sin):
    half = ROT_DIM // 2
    t1 = t[..., :half].astype(jnp.float32)
    t2 = t[..., half:ROT_DIM].astype(jnp.float32)
    rot = jnp.concatenate([t1 * cos - t2 * sin, t2 * cos + t1 * sin], axis=-1).astype(t.dtype)
    return jnp.concatenate([rot, t[..., ROT_DIM:]], axis=-1)


def causal_conv(u, w, b):
    S = u.shape[1]
    up = jnp.pad(u, ((0, 0), (CONV_K - 1, 0), (0, 0)))
    out = b
    for k in range(CONV_K):
        out = out + up[:, k:k + S] * w[k]
    return out


def ssd_chunked(xs, dt, A, Bm, Cm):
    Bsz, S = xs.shape[0], xs.shape[1]
    nc = S // SSD_CHUNK
    f32 = jnp.float32
    X = (xs.astype(f32) * dt[..., None]).reshape(Bsz, nc, SSD_CHUNK, SSM_GROUPS, SSM_HPG, SSM_HEADDIM)
    a = (dt * A).reshape(Bsz, nc, SSD_CHUNK, SSM_GROUPS, SSM_HPG)
    Bc = Bm.astype(f32).reshape(Bsz, nc, SSD_CHUNK, SSM_GROUPS, SSM_STATE)
    Cc = Cm.astype(f32).reshape(Bsz, nc, SSD_CHUNK, SSM_GROUPS, SSM_STATE)
    a_cs = jnp.cumsum(a, axis=2)
    causal = jnp.tril(jnp.ones((SSD_CHUNK, SSD_CHUNK), dtype=bool))[:, :, None, None]
    seg = a_cs[:, :, :, None] - a_cs[:, :, None, :]
    L = jnp.exp(jnp.where(causal, seg, -jnp.inf))
    cb = jnp.einsum('bclgn,bcsgn->bclsg', Cc, Bc)
    y_diag = jnp.einsum('bclsg,bclsgr,bcsgrp->bclgrp', cb, L, X)
    decay_to_end = jnp.exp(a_cs[:, :, -1:] - a_cs)
    states = jnp.einsum('bclgn,bclgr,bclgrp->bcgrpn', Bc, decay_to_end, X)
    chunk_decay = jnp.exp(a_cs[:, :, -1])

    def step(h, inp):
        st, dc = inp
        return h * dc[..., None, None] + st, h

    h0 = jnp.zeros((Bsz, SSM_GROUPS, SSM_HPG, SSM_HEADDIM, SSM_STATE), f32)
    _, prev = lax.scan(step, h0, (jnp.moveaxis(states, 1, 0), jnp.moveaxis(chunk_decay, 1, 0)))
    prev = jnp.moveaxis(prev, 0, 1)
    y_off = jnp.einsum('bclgn,bcgrpn,bclgr->bclgrp', Cc, prev, jnp.exp(a_cs))
    return (y_diag + y_off).reshape(Bsz, S, SSM_HEADS, SSM_HEADDIM)


def mamba2_mixer(x, norm_g, in_w, conv_w, conv_b, dt_bias, A_log, D_skip, gate_norm, out_w):
    Bsz, S, _ = x.shape
    f32 = jnp.float32
    h = rmsnorm(x, norm_g)
    zxbcdt = h @ in_w
    z = zxbcdt[..., :D_INNER]
    xbc = zxbcdt[..., D_INNER:D_INNER + CONV_DIM]
    dt_raw = zxbcdt[..., D_INNER + CONV_DIM:]
    xbc = jax.nn.silu(causal_conv(xbc, conv_w, conv_b))
    gn = SSM_GROUPS * SSM_STATE
    xs = xbc[..., :D_INNER].reshape(Bsz, S, SSM_HEADS, SSM_HEADDIM)
    Bm = xbc[..., D_INNER:D_INNER + gn].reshape(Bsz, S, SSM_GROUPS, SSM_STATE)
    Cm = xbc[..., D_INNER + gn:].reshape(Bsz, S, SSM_GROUPS, SSM_STATE)
    dt = jax.nn.softplus(dt_raw.astype(f32) + dt_bias.astype(f32))
    A = -jnp.exp(A_log.astype(f32))
    y = ssd_chunked(xs, dt, A, Bm, Cm)
    y = y + xs.astype(f32) * D_skip.astype(f32)[:, None]
    y = y.reshape(Bsz, S, D_INNER) * jax.nn.silu(z.astype(f32))
    y = y.reshape(Bsz, S, SSM_GROUPS, D_INNER // SSM_GROUPS)
    y = y * lax.rsqrt(jnp.mean(y * y, axis=-1, keepdims=True) + GATED_NORM_EPS)
    y = (y.reshape(Bsz, S, D_INNER) * gate_norm.astype(f32)).astype(x.dtype)
    return y @ out_w


def shared_kv(x, norm_g, kv_w, kv_b, cos, sin):
    Bsz, S, _ = x.shape
    kv = rmsnorm(x, norm_g) @ kv_w + kv_b
    k = kv[..., :KV_DIM].reshape(Bsz, S, N_KV_HEADS, HEAD_DIM)
    v = kv[..., KV_DIM:].reshape(Bsz, S, N_KV_HEADS, HEAD_DIM)
    return apply_partial_rope(k, cos, sin), v


def swa_sink_attention(x, norm_g, q_w, q_b, sinks, o_w, o_b, k, v, cos, sin):
    Bsz, S, _ = x.shape
    nb = S // WINDOW
    f32 = jnp.float32
    h = rmsnorm(x, norm_g)
    q = (h @ q_w + q_b).reshape(Bsz, S, N_Q_HEADS, HEAD_DIM)
    q = apply_partial_rope(q, cos, sin)
    qb = q.reshape(Bsz, nb, WINDOW, N_KV_HEADS, Q_PER_KV, HEAD_DIM)

    def band(t):
        tp = jnp.concatenate([jnp.zeros_like(t[:, :WINDOW]), t], axis=1)
        tp = tp.reshape(Bsz, nb + 1, WINDOW, N_KV_HEADS, HEAD_DIM)
        return jnp.concatenate([tp[:, :-1], tp[:, 1:]], axis=2)

    kb, vb = band(k), band(v)
    sink_logits = sinks.astype(f32).reshape(N_KV_HEADS, Q_PER_KV)
    qi = jnp.arange(WINDOW)[:, None]
    kj = jnp.arange(2 * WINDOW)[None, :]
    in_window = (kj > qi) & (kj <= qi + WINDOW)
    scale = HEAD_DIM ** -0.5

    def block(inp):
        qblk, kblk, vblk, n = inp
        s = jnp.einsum('bqgrd,bkgd->bgrqk', qblk, kblk).astype(f32) * scale
        valid = in_window & (n * WINDOW - WINDOW + kj >= 0)
        s = jnp.where(valid, s, -jnp.inf)
        sink = jnp.broadcast_to(sink_logits[None, :, :, None, None], s.shape[:-1] + (1,))
        pr = jax.nn.softmax(jnp.concatenate([s, sink], axis=-1), axis=-1)[..., :-1]
        return jnp.einsum('bgrqk,bkgd->bqgrd', pr.astype(vblk.dtype), vblk)

    o = lax.map(block, (jnp.moveaxis(qb, 1, 0), jnp.moveaxis(kb, 1, 0), jnp.moveaxis(vb, 1, 0),
                        jnp.arange(nb)))
    o = jnp.moveaxis(o, 0, 1).reshape(Bsz, S, N_Q_HEADS * HEAD_DIM)
    return o @ o_w + o_b


def peer_ffn(x, norm_g, q_w, sub_keys, u, v):
    Bsz, S, D = x.shape
    T = Bsz * S
    h = rmsnorm(x, norm_g).reshape(T, D)
    q = (h @ q_w).reshape(T, PEER_HEADS, 2, PEER_HALF)
    s = jnp.einsum('thcd,ckd->thck', q, sub_keys).astype(jnp.float32)
    s1, i1 = lax.top_k(s[:, :, 0], PEER_TOPK)
    s2, i2 = lax.top_k(s[:, :, 1], PEER_TOPK)
    cand_s = (s1[..., :, None] + s2[..., None, :]).reshape(T, PEER_HEADS, PEER_TOPK * PEER_TOPK)
    cand_i = (i1[..., :, None] * N_KEYS + i2[..., None, :]).reshape(T, PEER_HEADS, PEER_TOPK * PEER_TOPK)
    best_s, best_pos = lax.top_k(cand_s, PEER_TOPK)
    idx = jnp.take_along_axis(cand_i, best_pos, axis=-1)
    gate = jax.nn.softmax(best_s, axis=-1).astype(x.dtype)
    nblk = T // PEER_BLOCK

    def block(inp):
        hb, ib, gb = inp
        a = jnp.einsum('nd,nhkd->nhk', hb, u[ib])
        w = gb * jax.nn.gelu(a, approximate=False)
        return jnp.einsum('nhk,nhkd->nd', w, v[ib])

    out = lax.map(block, (h.reshape(nblk, PEER_BLOCK, D),
                          idx.reshape(nblk, PEER_BLOCK, PEER_HEADS, PEER_TOPK),
                          gate.reshape(nblk, PEER_BLOCK, PEER_HEADS, PEER_TOPK)))
    return out.reshape(Bsz, S, D)


def ple_add(x, p_i, norm_g, proj, gate_w):
    gate = jax.nn.sigmoid(rmsnorm(x, norm_g) @ gate_w)
    return x + (p_i @ proj) * gate


def setup_inputs(seed: int = 0) -> dict:
    key = jax.random.key(seed)
    ks = jax.random.split(key, 32)
    f32 = jnp.float32

    def nrm(k, shape, scale):
        return jax.random.normal(k, shape, f32) * scale

    def gain(k, shape):
        return 1.0 + 0.05 * jax.random.normal(k, shape, f32)

    dt0 = jnp.exp(jax.random.uniform(ks[6], (N_A_LAYERS, SSM_HEADS), f32,
                                     minval=math.log(1e-3), maxval=math.log(1e-1)))
    inp = {
        'x': nrm(ks[0], (BATCH, SEQ, D_MODEL), 1.0),
        'p': nrm(ks[1], (DEPTH, BATCH, SEQ, PLE_DIM), 1.0),
        'positions': jnp.arange(SEQ, dtype=jnp.int32)[None, :]
                     + jax.random.randint(ks[2], (BATCH, 1), 0, 4096, dtype=jnp.int32),
        'ssm_norm': gain(ks[3], (N_A_LAYERS, D_MODEL)),
        'ssm_in_w': nrm(ks[4], (N_A_LAYERS, D_MODEL, D_IN_PROJ), D_MODEL ** -0.5),
        'ssm_conv_w': nrm(ks[5], (N_A_LAYERS, CONV_K, CONV_DIM), CONV_K ** -0.5),
        'ssm_conv_b': nrm(ks[7], (N_A_LAYERS, CONV_DIM), 0.02),
        'ssm_dt_bias': dt0 + jnp.log(-jnp.expm1(-dt0)),
        'ssm_A_log': jnp.log(jax.random.uniform(ks[8], (N_A_LAYERS, SSM_HEADS), f32, minval=1.0, maxval=16.0)),
        'ssm_D': gain(ks[9], (N_A_LAYERS, SSM_HEADS)),
        'ssm_gate_norm': gain(ks[10], (N_A_LAYERS, D_INNER)),
        'ssm_out_w': nrm(ks[11], (N_A_LAYERS, D_INNER, D_MODEL), D_INNER ** -0.5),
        'kv_norm': gain(ks[12], (D_MODEL,)),
        'kv_w': nrm(ks[13], (D_MODEL, 2 * KV_DIM), D_MODEL ** -0.5),
        'kv_b': nrm(ks[14], (2 * KV_DIM,), 0.02),
        'attn_norm': gain(ks[15], (N_B_LAYERS, D_MODEL)),
        'q_w': nrm(ks[16], (N_B_LAYERS, D_MODEL, N_Q_HEADS * HEAD_DIM), D_MODEL ** -0.5),
        'q_b': nrm(ks[17], (N_B_LAYERS, N_Q_HEADS * HEAD_DIM), 0.02),
        'sinks': nrm(ks[18], (N_B_LAYERS, N_Q_HEADS), 0.5),
        'o_w': nrm(ks[19], (N_B_LAYERS, N_Q_HEADS * HEAD_DIM, D_MODEL), (N_Q_HEADS * HEAD_DIM) ** -0.5),
        'o_b': nrm(ks[20], (N_B_LAYERS, D_MODEL), 0.02),
        'peer_norm': gain(ks[21], (DEPTH, D_MODEL)),
        'peer_q_w': nrm(ks[22], (DEPTH, D_MODEL, PEER_HEADS * PEER_DK), D_MODEL ** -0.5),
        'peer_sub_keys': nrm(ks[23], (DEPTH, 2, N_KEYS, PEER_HALF), PEER_HALF ** -0.5),
        'peer_u': nrm(ks[24], (DEPTH, N_EXPERTS, D_MODEL), D_MODEL ** -0.5),
        'peer_v': nrm(ks[25], (DEPTH, N_EXPERTS, D_MODEL), PEER_HEADS ** -0.5),
        'ple_norm': gain(ks[26], (DEPTH, D_MODEL)),
        'ple_proj': nrm(ks[27], (DEPTH, PLE_DIM, D_MODEL), PLE_DIM ** -0.5),
        'ple_gate_w': nrm(ks[28], (DEPTH, D_MODEL, D_MODEL), D_MODEL ** -0.5),
        'final_norm': gain(ks[29], (D_MODEL,)),
    }
    return inp


def reference(x, p, positions, ssm_norm, ssm_in_w, ssm_conv_w, ssm_conv_b, ssm_dt_bias, ssm_A_log,
              ssm_D, ssm_gate_norm, ssm_out_w, kv_norm, kv_w, kv_b, attn_norm, q_w, q_b, sinks,
              o_w, o_b, peer_norm, peer_q_w, peer_sub_keys, peer_u, peer_v, ple_norm, ple_proj,
              ple_gate_w, final_norm):
    cos, sin = rope_tables(positions)
    k_shared, v_shared = None, None
    for i in range(DEPTH):
        if i < N_A_LAYERS:
            j = i
            x = x + mamba2_mixer(x, ssm_norm[j], ssm_in_w[j], ssm_conv_w[j], ssm_conv_b[j],
                                 ssm_dt_bias[j], ssm_A_log[j], ssm_D[j], ssm_gate_norm[j], ssm_out_w[j])
        else:
            j = i - N_A_LAYERS
            x = x + swa_sink_attention(x, attn_norm[j], q_w[j], q_b[j], sinks[j], o_w[j], o_b[j],
                                       k_shared, v_shared, cos, sin)
        x = x + peer_ffn(x, peer_norm[i], peer_q_w[i], peer_sub_keys[i], peer_u[i], peer_v[i])
        x = ple_add(x, p[i], ple_norm[i], ple_proj[i], ple_gate_w[i])
        if i == N_A_LAYERS - 1:
            k_shared, v_shared = shared_kv(x, kv_norm, kv_w, kv_b, cos, sin)
    return rmsnorm(x, final_norm)
```

```cpp
#include <hip/hip_runtime.h>
#include <hip/hip_cooperative_groups.h>
#include <stdint.h>
#include <stdio.h>
namespace cg = cooperative_groups;

typedef unsigned short bf16_t;
typedef short bf16x8 __attribute__((ext_vector_type(8)));
typedef float f32x4 __attribute__((ext_vector_type(4)));
typedef unsigned u32x4 __attribute__((ext_vector_type(4)));
typedef unsigned u32x2 __attribute__((ext_vector_type(2)));

constexpr int T = 32768;
constexpr int SEQ = 4096;
constexpr int DM = 1024;
constexpr int NTHREADS = 256;

constexpr size_t MiB = 1u << 20;
constexpr size_t OFF_W_IN  = 1 * MiB;
constexpr size_t OFF_W_OUT = OFF_W_IN  + (size_t)6272 * 1024 * 2;
constexpr size_t OFF_W_PQ  = OFF_W_OUT + (size_t)1024 * 2048 * 2;
constexpr size_t OFF_W_KV  = OFF_W_PQ  + (size_t)2 * 2048 * 1024 * 2;
constexpr size_t OFF_W_Q   = OFF_W_KV  + (size_t)256 * 1024 * 2;
constexpr size_t OFF_W_O   = OFF_W_Q   + (size_t)1024 * 1024 * 2;
constexpr size_t OFF_W_PG  = OFF_W_O   + (size_t)1024 * 1024 * 2;
constexpr size_t OFF_W_PP  = OFF_W_PG  + (size_t)2 * 1024 * 1024 * 2;
constexpr size_t OFF_W_END = OFF_W_PP  + (size_t)2 * 1024 * 256 * 2;
static_assert(OFF_W_END <= 40 * MiB, "weights region");
constexpr size_t OFF_Z     = 40 * MiB;
constexpr size_t OFF_DT    = OFF_Z + 384 * MiB;
constexpr size_t OFF_SSQ   = OFF_DT + 4 * MiB;
constexpr size_t OFF_U     = OFF_Z;
constexpr size_t OFF_V     = OFF_Z + 64 * MiB;
constexpr size_t OFF_P     = OFF_Z + 128 * MiB;
constexpr size_t OFF_XRES  = OFF_Z + 160 * MiB;
constexpr size_t OFF_H     = OFF_Z + 288 * MiB;
constexpr size_t OFF_IDX   = OFF_Z + 352 * MiB;
constexpr size_t OFF_GATE  = OFF_Z + 368 * MiB;
constexpr size_t OFF_KV    = OFF_Z + 384 * MiB;
constexpr size_t OFF_AO    = OFF_Z + 400 * MiB;
constexpr size_t WS_END    = OFF_Z + 464 * MiB;
static_assert(WS_END <= 512 * MiB, "workspace");

struct Params {
    const float* in[30];
    float* out;
    unsigned char* ws;
};

__device__ __forceinline__ bf16_t f2bf(float f) { unsigned u = __float_as_uint(f); u += 0x7fffu + ((u >> 16) & 1u); return (bf16_t)(u >> 16); }
__device__ __forceinline__ float bf2f(bf16_t h) { return __uint_as_float(((unsigned)h) << 16); }
__device__ __forceinline__ unsigned pack2(float lo, float hi) { return (unsigned)f2bf(lo) | ((unsigned)f2bf(hi) << 16); }
__device__ __forceinline__ float bflo(unsigned u) { return __uint_as_float(u << 16); }
__device__ __forceinline__ float bfhi(unsigned u) { return __uint_as_float(u & 0xffff0000u); }
__device__ __forceinline__ float wave_sum(float v) {
#pragma unroll
    for (int o = 32; o; o >>= 1) v += __shfl_xor(v, o);
    return v;
}
__device__ __forceinline__ float wave_max(float v) {
#pragma unroll
    for (int o = 32; o; o >>= 1) v = fmaxf(v, __shfl_xor(v, o));
    return v;
}
__device__ __forceinline__ float rl_f(float v, int l) { return __uint_as_float((unsigned)__builtin_amdgcn_readlane((int)__float_as_uint(v), l)); }
__device__ __forceinline__ float silu_f(float a) { return a * __builtin_amdgcn_rcpf(1.f + __expf(-a)); }

__device__ __forceinline__ void transpose_convert(const float* __restrict__ src, int K, int N, int Npad, bf16_t* __restrict__ dst, int bid, int nb, float* sm) {
    const int tilesK = K / 64, tilesN = Npad / 64, tid = threadIdx.x;
    for (int tile = bid; tile < tilesK * tilesN; tile += nb) {
        const int tk = tile % tilesK, tn = tile / tilesK, k0 = tk * 64, n0 = tn * 64;
#pragma unroll
        for (int i = 0; i < 4; i++) {
            const int kr = (tid >> 4) + 16 * i, nc = (tid & 15) * 4;
            float4 v = make_float4(0.f, 0.f, 0.f, 0.f);
            if (n0 + nc < N) v = *(const float4*)(src + (size_t)(k0 + kr) * N + n0 + nc);
            sm[kr * 65 + nc + 0] = v.x; sm[kr * 65 + nc + 1] = v.y; sm[kr * 65 + nc + 2] = v.z; sm[kr * 65 + nc + 3] = v.w;
        }
        __syncthreads();
        {
            const int n = tid >> 2, kc = (tid & 3) * 16;
            unsigned o[8];
#pragma unroll
            for (int j = 0; j < 8; j++) o[j] = pack2(sm[(kc + 2 * j) * 65 + n], sm[(kc + 2 * j + 1) * 65 + n]);
            bf16_t* d = dst + (size_t)(n0 + n) * K + k0 + kc;
            *(u32x4*)d = (u32x4){o[0], o[1], o[2], o[3]};
            *(u32x4*)(d + 8) = (u32x4){o[4], o[5], o[6], o[7]};
        }
        __syncthreads();
    }
}

__device__ __forceinline__ void convert_flat(const float* __restrict__ src, bf16_t* __restrict__ dst, size_t n, int bid, int nb) {
    const size_t nvec = n / 8;
    for (size_t i = (size_t)bid * NTHREADS + threadIdx.x; i < nvec; i += (size_t)nb * NTHREADS) {
        const float4 a = ((const float4*)src)[2 * i], b = ((const float4*)src)[2 * i + 1];
        ((u32x4*)dst)[i] = (u32x4){pack2(a.x, a.y), pack2(a.z, a.w), pack2(b.x, b.y), pack2(b.z, b.w)};
    }
}

__device__ __forceinline__ void rmsnorm_rows(const float* __restrict__ x, const float* __restrict__ g, bf16_t* outb, float* outf, float eps, int bid, int nb) {
    const int wave = threadIdx.x >> 6, lane = threadIdx.x & 63;
    for (int row = bid * 4 + wave; row < T; row += nb * 4) {
        const float4* xr = (const float4*)(x + (size_t)row * DM);
        float4 v[4]; float ss = 0.f;
#pragma unroll
        for (int i = 0; i < 4; i++) { v[i] = xr[i * 64 + lane]; ss += v[i].x * v[i].x + v[i].y * v[i].y + v[i].z * v[i].z + v[i].w * v[i].w; }
        ss = wave_sum(ss);
        const float r = rsqrtf(ss * (1.f / DM) + eps);
#pragma unroll
        for (int i = 0; i < 4; i++) {
            const float4 gg = ((const float4*)g)[i * 64 + lane];
            const float4 o = make_float4(v[i].x * r * gg.x, v[i].y * r * gg.y, v[i].z * r * gg.z, v[i].w * r * gg.w);
            if (outb) *(u32x2*)(outb + (size_t)row * DM + (i * 64 + lane) * 4) = (u32x2){pack2(o.x, o.y), pack2(o.z, o.w)};
            if (outf) ((float4*)(outf + (size_t)row * DM))[i * 64 + lane] = o;
        }
    }
}

constexpr int G_LDS = 72;
template <class Epi>
__device__ __forceinline__ void gemm_phase(const bf16_t* __restrict__ A, int lda, const bf16_t* __restrict__ Bt, int ldb, int M, int N, int K, const Epi& epi, int bid, int nb, bf16_t* sm) {
    const int tilesM = M / 128, tilesN = N / 128;
    const int tid = threadIdx.x, lane = tid & 63, w = tid >> 6, wm = w >> 1, wn = w & 1, l15 = lane & 15, quad = lane >> 4;
    bf16_t* sA = sm; bf16_t* sB = sm + 128 * G_LDS;
    const int srow = tid >> 3, sch = (tid & 7) * 8;
    for (int tile = bid; tile < tilesM * tilesN; tile += nb) {
        const int tm = tile % tilesM, tn = tile / tilesM, m0 = tm * 128, n0 = tn * 128;
        f32x4 acc[4][4];
#pragma unroll
        for (int i = 0; i < 4; i++)
#pragma unroll
            for (int j = 0; j < 4; j++) acc[i][j] = (f32x4){0.f, 0.f, 0.f, 0.f};
        const bf16_t* Ag = A + (size_t)(m0 + srow) * lda + sch;
        const bf16_t* Bg = Bt + (size_t)(n0 + srow) * ldb + sch;
        u32x4 ra[4], rb[4];
#pragma unroll
        for (int i = 0; i < 4; i++) { ra[i] = *(const u32x4*)(Ag + (size_t)i * 32 * lda); rb[i] = *(const u32x4*)(Bg + (size_t)i * 32 * ldb); }
        const int nk = K / 64;
        for (int kt = 0; kt < nk; kt++) {
#pragma unroll
            for (int i = 0; i < 4; i++) { *(u32x4*)(sA + (srow + i * 32) * G_LDS + sch) = ra[i]; *(u32x4*)(sB + (srow + i * 32) * G_LDS + sch) = rb[i]; }
            __syncthreads();
            if (kt + 1 < nk) {
                const int k0 = (kt + 1) * 64;
#pragma unroll
                for (int i = 0; i < 4; i++) { ra[i] = *(const u32x4*)(Ag + (size_t)i * 32 * lda + k0); rb[i] = *(const u32x4*)(Bg + (size_t)i * 32 * ldb + k0); }
            }
#pragma unroll
            for (int kk = 0; kk < 2; kk++) {
                bf16x8 af[4], bfr[4];
#pragma unroll
                for (int i = 0; i < 4; i++) af[i] = *(const bf16x8*)(sA + (wm * 64 + i * 16 + l15) * G_LDS + kk * 32 + quad * 8);
#pragma unroll
                for (int j = 0; j < 4; j++) bfr[j] = *(const bf16x8*)(sB + (wn * 64 + j * 16 + l15) * G_LDS + kk * 32 + quad * 8);
#pragma unroll
                for (int i = 0; i < 4; i++)
#pragma unroll
                    for (int j = 0; j < 4; j++) acc[i][j] = __builtin_amdgcn_mfma_f32_16x16x32_bf16(bfr[j], af[i], acc[i][j], 0, 0, 0);
            }
            __syncthreads();
        }
#pragma unroll
        for (int i = 0; i < 4; i++)
#pragma unroll
            for (int j = 0; j < 4; j++) { epi(m0 + wm * 64 + i * 16 + l15, n0 + wn * 64 + j * 16 + quad * 4, acc[i][j]); asm volatile("" ::: "memory"); }
    }
}

struct EpiInProj {
    bf16_t* zx; float* dtraw;
    __device__ __forceinline__ void operator()(int row, int col, f32x4 v) const {
        if (col < 6144) *(u32x2*)(zx + (size_t)row * 6144 + col) = (u32x2){pack2(v[0], v[1]), pack2(v[2], v[3])};
        else if (col < 6176) *(f32x4*)(dtraw + (size_t)row * 32 + (col - 6144)) = v;
    }
};
struct EpiResid {
    const float* resid; float* out; const float* bias;
    __device__ __forceinline__ void operator()(int row, int col, f32x4 v) const {
        const f32x4 r = *(const f32x4*)(resid + (size_t)row * DM + col);
        f32x4 b = (f32x4){0.f, 0.f, 0.f, 0.f};
        if (bias) b = *(const f32x4*)(bias + col);
        *(f32x4*)(out + (size_t)row * DM + col) = r + v + b;
    }
};
struct EpiBf16 {
    bf16_t* out; int ldc; const float* bias; float scale;
    __device__ __forceinline__ void operator()(int row, int col, f32x4 v) const {
        f32x4 b = (f32x4){0.f, 0.f, 0.f, 0.f};
        if (bias) b = *(const f32x4*)(bias + col);
        v = (v + b) * scale;
        *(u32x2*)(out + (size_t)row * ldc + col) = (u32x2){pack2(v[0], v[1]), pack2(v[2], v[3])};
    }
};
struct EpiPle {
    float* xres; const bf16_t* tmp;
    __device__ __forceinline__ void operator()(int row, int col, f32x4 v) const {
        const u32x2 tb = *(const u32x2*)(tmp + (size_t)row * DM + col);
        f32x4 x = *(f32x4*)(xres + (size_t)row * DM + col);
        x[0] += bflo(tb.x) * __builtin_amdgcn_rcpf(1.f + __expf(-v[0])); x[1] += bfhi(tb.x) * __builtin_amdgcn_rcpf(1.f + __expf(-v[1]));
        x[2] += bflo(tb.y) * __builtin_amdgcn_rcpf(1.f + __expf(-v[2])); x[3] += bfhi(tb.y) * __builtin_amdgcn_rcpf(1.f + __expf(-v[3]));
        *(f32x4*)(xres + (size_t)row * DM + col) = x;
    }
};

__device__ __forceinline__ void ssd_seq(const bf16_t* __restrict__ zx, const float* __restrict__ dtraw, const float* __restrict__ conv_w, const float* __restrict__ conv_b,
                        const float* __restrict__ dt_bias, const float* __restrict__ A_log, const float* __restrict__ Dskip,
                        bf16_t* __restrict__ ybuf, float* __restrict__ ssq, int bid, int nb, float* sm) {
    float* xs = sm;
    float* Bs = xs + 32 * 64;
    float* Cs = Bs + 32 * 128;
    float* ys = Cs + 32 * 128;
    float* dts = ys + 32 * 64;
    float* dAs = dts + 32;
    const int tid = threadIdx.x, lane = tid & 63;
    for (int item = bid; item < 256; item += nb) {
        const int b = item >> 5, head = item & 31, g = head >> 2;
        const float Aneg = -__expf(A_log[head]), dtb = dt_bias[head], Dh = Dskip[head];
        float h[32];
#pragma unroll
        for (int n = 0; n < 32; n++) h[n] = 0.f;
        const int p = tid >> 2, nq = tid & 3;
        for (int sc = 0; sc < 128; sc++) {
            const int s0 = sc * 32;
            for (int k = 0; k < 40; k++) {
                const int idx = tid + 256 * k, tt = idx / 320, c = idx % 320;
                int ch;
                if (c < 64) ch = head * 64 + c; else if (c < 192) ch = 2048 + g * 128 + (c - 64); else ch = 3072 + g * 128 + (c - 192);
                const int s = s0 + tt;
                float a = conv_b[ch];
#pragma unroll
                for (int kk = 0; kk < 4; kk++) {
                    const int sp = s - 3 + kk;
                    if (sp >= 0) a += conv_w[kk * 4096 + ch] * bf2f(zx[((size_t)(b * SEQ + sp)) * 6144 + 2048 + ch]);
                }
                a = silu_f(a);
                if (c < 64) xs[tt * 64 + c] = a; else if (c < 192) Bs[tt * 128 + (c - 64)] = a; else Cs[tt * 128 + (c - 192)] = a;
            }
            if (tid < 32) {
                const float v = dtraw[((size_t)(b * SEQ + s0 + tid)) * 32 + head] + dtb;
                const float dt = v > 20.f ? v : log1pf(__expf(v));
                dts[tid] = dt; dAs[tid] = __expf(dt * Aneg);
            }
            __syncthreads();
            for (int tt = 0; tt < 32; tt++) {
                const float xv = xs[tt * 64 + p] * dts[tt], dec = dAs[tt];
                const float4* Bp = (const float4*)(Bs + tt * 128 + nq * 32);
                const float4* Cp = (const float4*)(Cs + tt * 128 + nq * 32);
                float acc = 0.f;
#pragma unroll
                for (int n4 = 0; n4 < 8; n4++) {
                    const float4 bv = Bp[n4], cv = Cp[n4];
                    h[n4 * 4 + 0] = h[n4 * 4 + 0] * dec + xv * bv.x; acc += h[n4 * 4 + 0] * cv.x;
                    h[n4 * 4 + 1] = h[n4 * 4 + 1] * dec + xv * bv.y; acc += h[n4 * 4 + 1] * cv.y;
                    h[n4 * 4 + 2] = h[n4 * 4 + 2] * dec + xv * bv.z; acc += h[n4 * 4 + 2] * cv.z;
                    h[n4 * 4 + 3] = h[n4 * 4 + 3] * dec + xv * bv.w; acc += h[n4 * 4 + 3] * cv.w;
                }
                acc += __shfl_xor(acc, 1); acc += __shfl_xor(acc, 2);
                if (nq == 0) ys[tt * 64 + p] = acc;
            }
            __syncthreads();
#pragma unroll
            for (int k = 0; k < 8; k++) {
                const int idx = tid + 256 * k, tt = idx >> 6, pp = idx & 63;
                const size_t t = (size_t)(b * SEQ + s0 + tt);
                const float yv = ys[tt * 64 + pp] + xs[tt * 64 + pp] * Dh;
                const float zv = bf2f(zx[t * 6144 + head * 64 + pp]);
                const float yg = yv * silu_f(zv);
                ybuf[t * 2048 + head * 64 + pp] = f2bf(yg);
                const float s2 = wave_sum(yg * yg);
                if (lane == 0) ssq[t * 32 + head] = s2;
            }
            __syncthreads();
        }
    }
}

__device__ __forceinline__ void ynorm_phase(bf16_t* ybuf, const float* __restrict__ ssq, const float* __restrict__ gate_norm, int bid, int nb) {
    const size_t nvec = (size_t)T * 2048 / 8;
    for (size_t i = (size_t)bid * NTHREADS + threadIdx.x; i < nvec; i += (size_t)nb * NTHREADS) {
        const size_t t = i >> 8; const int c = (int)(i & 255) * 8, g = c >> 8;
        const f32x4 s4 = *(const f32x4*)(ssq + t * 32 + g * 4);
        const float r = rsqrtf((s4[0] + s4[1] + s4[2] + s4[3]) * (1.f / 256.f) + 1e-5f);
        u32x4 v = *(u32x4*)(ybuf + t * 2048 + c);
        const float4 g0 = *(const float4*)(gate_norm + c), g1 = *(const float4*)(gate_norm + c + 4);
        v.x = pack2(bflo(v.x) * r * g0.x, bfhi(v.x) * r * g0.y); v.y = pack2(bflo(v.y) * r * g0.z, bfhi(v.y) * r * g0.w);
        v.z = pack2(bflo(v.z) * r * g1.x, bfhi(v.z) * r * g1.y); v.w = pack2(bflo(v.w) * r * g1.z, bfhi(v.w) * r * g1.w);
        *(u32x4*)(ybuf + t * 2048 + c) = v;
    }
}

__device__ __forceinline__ void rope_phase(bf16_t* qatt, bf16_t* kvbuf, const int* __restrict__ pos, int bid, int nb) {
    const int total = T * 18 * 8;
    for (int i = bid * NTHREADS + threadIdx.x; i < total; i += nb * NTHREADS) {
        const int pr = i & 7, hd = (i >> 3) % 18, t = i / 144;
        const float inv = exp2f(-(float)pr * (18.931568569324174f / 8.f));
        const double rev = (double)pos[t] * (double)inv * 0.15915494309189535;
        const float fr = (float)(rev - floor(rev));
        const float sn = __builtin_amdgcn_sinf(fr), cs = __builtin_amdgcn_cosf(fr);
        bf16_t* ptr = hd < 16 ? qatt + (size_t)t * 1024 + hd * 64 : kvbuf + (size_t)t * 256 + (hd - 16) * 64;
        const float t1 = bf2f(ptr[pr]), t2 = bf2f(ptr[pr + 8]);
        ptr[pr] = f2bf(t1 * cs - t2 * sn); ptr[pr + 8] = f2bf(t2 * cs + t1 * sn);
    }
}

__device__ __forceinline__ void attn_simple(const bf16_t* __restrict__ qatt, const bf16_t* __restrict__ kvbuf, const float* __restrict__ sinks, bf16_t* __restrict__ aout, int bid, int nb) {
    const int w = threadIdx.x >> 6, lane = threadIdx.x & 63;
    const int nitems = T * 16;
    for (int item = bid * 4 + w; item < nitems; item += nb * 4) {
        const int t = item >> 4, hq = item & 15, g = hq >> 3, s = t & (SEQ - 1);
        const float qd = bf2f(qatt[(size_t)t * 1024 + hq * 64 + lane]);
        const float sink = sinks[hq];
        float sc[2]; bool valid[2];
#pragma unroll
        for (int kh = 0; kh < 2; kh++) {
            const int kk = lane + 64 * kh; const int sk = s - 127 + kk;
            valid[kh] = sk >= 0;
            const int row = valid[kh] ? (t - 127 + kk) : t;
            const bf16_t* kr = kvbuf + (size_t)row * 256 + g * 64;
            float a = 0.f;
#pragma unroll
            for (int c = 0; c < 8; c++) {
                const u32x4 kv = *(const u32x4*)(kr + c * 8);
                a += rl_f(qd, c * 8 + 0) * bflo(kv.x) + rl_f(qd, c * 8 + 1) * bfhi(kv.x) + rl_f(qd, c * 8 + 2) * bflo(kv.y) + rl_f(qd, c * 8 + 3) * bfhi(kv.y)
                   + rl_f(qd, c * 8 + 4) * bflo(kv.z) + rl_f(qd, c * 8 + 5) * bfhi(kv.z) + rl_f(qd, c * 8 + 6) * bflo(kv.w) + rl_f(qd, c * 8 + 7) * bfhi(kv.w);
            }
            sc[kh] = valid[kh] ? a : -INFINITY;
        }
        float m = wave_max(fmaxf(sc[0], sc[1])); m = fmaxf(m, sink);
        const float p0 = valid[0] ? __expf(sc[0] - m) : 0.f, p1 = valid[1] ? __expf(sc[1] - m) : 0.f;
        const float denom = wave_sum(p0 + p1) + __expf(sink - m);
        float o = 0.f;
        const int tb = t - s;
        for (int kk = 0; kk < 64; kk++) {
            const float pk = rl_f(p0, kk); int row = t - 127 + kk; row = row < tb ? tb : row;
            o += pk * bf2f(kvbuf[(size_t)row * 256 + 128 + g * 64 + lane]);
        }
        for (int kk = 0; kk < 64; kk++) {
            const float pk = rl_f(p1, kk); int row = t - 63 + kk; row = row < tb ? tb : row;
            o += pk * bf2f(kvbuf[(size_t)row * 256 + 128 + g * 64 + lane]);
        }
        aout[(size_t)t * 1024 + hq * 64 + lane] = f2bf(o / denom);
    }
}

__device__ const unsigned char PAIR_I[64] = {0,0,0,0,0,0,0,0,0,0,0,0,0,0,0,0, 1,1,1,1,1,1,1,1, 2,2,2,2,2, 3,3,3,3, 4,4,4, 5,5, 6,6, 7,7, 8,9,10,11,12,13,14,15, 0,0,0,0,0,0,0,0,0,0,0,0,0,0};
__device__ const unsigned char PAIR_J[64] = {0,1,2,3,4,5,6,7,8,9,10,11,12,13,14,15, 0,1,2,3,4,5,6,7, 0,1,2,3,4, 0,1,2,3, 0,1,2, 0,1, 0,1, 0,1, 0,0,0,0,0,0,0,0, 0,0,0,0,0,0,0,0,0,0,0,0,0,0};
__device__ __forceinline__ void peer_route(const bf16_t* __restrict__ qbuf, const float* __restrict__ sk, int* __restrict__ idxb, float* __restrict__ gateb, int bid, int nb, float* sm) {
    const int w = threadIdx.x >> 6, lane = threadIdx.x & 63;
    float* base = sm + w * 768;
    float* qs = base;
    float* scs = base + 256;
    float* tops = base + 512;
    int* topi = (int*)(base + 544);
    float* cand = base + 576;
    float* sels = base + 640;
    int* seli = (int*)(base + 656);
    const int nitems = T * 8;
    const int niter = (nitems + nb * 4 - 1) / (nb * 4);
    for (int it = 0; it < niter; it++) {
        int item = (it * nb + bid) * 4 + w;
        const bool active = item < nitems;
        if (!active) item = 0;
        const int t = item >> 3, hh = item & 7;
        {
            const u32x2 qv = *(const u32x2*)(qbuf + (size_t)t * 2048 + hh * 256 + lane * 4);
            *(float4*)(qs + lane * 4) = make_float4(bflo(qv.x), bfhi(qv.x), bflo(qv.y), bfhi(qv.y));
        }
        __syncthreads();
        float myv[2][2];
#pragma unroll
        for (int c = 0; c < 2; c++)
#pragma unroll
            for (int kh = 0; kh < 2; kh++) {
                const int key = lane + 64 * kh;
                const float4* skr = (const float4*)(sk + (size_t)(c * 128 + key) * 128);
                float s = 0.f;
#pragma unroll 8
                for (int d4 = 0; d4 < 32; d4++) {
                    const float4 kv = skr[d4]; const float4 qv = *(const float4*)(qs + c * 128 + d4 * 4);
                    s += kv.x * qv.x + kv.y * qv.y + kv.z * qv.z + kv.w * qv.w;
                }
                myv[c][kh] = s; scs[c * 128 + key] = s;
            }
        __syncthreads();
#pragma unroll
        for (int c = 0; c < 2; c++) {
            int r0 = 0, r1 = 0; const float v0 = myv[c][0], v1 = myv[c][1]; const int k0 = lane, k1 = lane + 64;
            for (int k4 = 0; k4 < 32; k4++) {
                const float4 o = *(const float4*)(scs + c * 128 + k4 * 4);
                const float ov[4] = {o.x, o.y, o.z, o.w};
#pragma unroll
                for (int i = 0; i < 4; i++) {
                    const int k = k4 * 4 + i;
                    r0 += (ov[i] > v0 || (ov[i] == v0 && k < k0)) ? 1 : 0;
                    r1 += (ov[i] > v1 || (ov[i] == v1 && k < k1)) ? 1 : 0;
                }
            }
            if (r0 < 16) { tops[c * 16 + r0] = v0; topi[c * 16 + r0] = k0; }
            if (r1 < 16) { tops[c * 16 + r1] = v1; topi[c * 16 + r1] = k1; }
        }
        __syncthreads();
        const int pi = PAIR_I[lane], pj = PAIR_J[lane];
        const float cv = lane < 50 ? tops[pi] + tops[16 + pj] : -INFINITY;
        cand[lane] = cv;
        __syncthreads();
        int r = 0;
        for (int k = 0; k < 64; k++) { const float ov = cand[k]; r += (ov > cv || (ov == cv && k < lane)) ? 1 : 0; }
        if (lane < 50 && r < 16) { sels[r] = cv; seli[r] = topi[pi] * 128 + topi[16 + pj]; }
        __syncthreads();
        if (lane < 16 && active) {
            const float m = sels[0]; float sum = 0.f;
#pragma unroll
            for (int k = 0; k < 16; k++) sum += __expf(sels[k] - m);
            idxb[(size_t)t * 128 + hh * 16 + lane] = seli[lane];
            gateb[(size_t)t * 128 + hh * 16 + lane] = __expf(sels[lane] - m) / sum;
        }
        __syncthreads();
    }
}

__device__ __forceinline__ void peer_expert(const bf16_t* __restrict__ hbuf, const bf16_t* __restrict__ ub, const bf16_t* __restrict__ vb, const int* __restrict__ idxb,
                            const float* __restrict__ gateb, float* xres, int bid, int nb, float* sm) {
    const int w = threadIdx.x >> 6, lane = threadIdx.x & 63;
    float* scr = sm + w * (64 * 65);
    const int niter = (T + nb * 4 - 1) / (nb * 4);
    for (int it = 0; it < niter; it++) {
        int t = (it * nb + bid) * 4 + w;
        const bool active = t < T;
        if (!active) t = 0;
        float h[16];
        {
            const u32x4 a = *(const u32x4*)(hbuf + (size_t)t * DM + lane * 8), b = *(const u32x4*)(hbuf + (size_t)t * DM + 512 + lane * 8);
            h[0] = bflo(a.x); h[1] = bfhi(a.x); h[2] = bflo(a.y); h[3] = bfhi(a.y); h[4] = bflo(a.z); h[5] = bfhi(a.z); h[6] = bflo(a.w); h[7] = bfhi(a.w);
            h[8] = bflo(b.x); h[9] = bfhi(b.x); h[10] = bflo(b.y); h[11] = bfhi(b.y); h[12] = bflo(b.z); h[13] = bfhi(b.z); h[14] = bflo(b.w); h[15] = bfhi(b.w);
        }
        float acc[16];
#pragma unroll
        for (int j = 0; j < 16; j++) acc[j] = 0.f;
        for (int half = 0; half < 2; half++) {
            const int my_idx = idxb[(size_t)t * 128 + half * 64 + lane];
            const float my_gate = gateb[(size_t)t * 128 + half * 64 + lane];
#pragma unroll 8
            for (int e = 0; e < 64; e++) {
                const int ie = __builtin_amdgcn_readlane(my_idx, e);
                const bf16_t* ur = ub + (size_t)ie * DM;
                const u32x4 a = *(const u32x4*)(ur + lane * 8), b = *(const u32x4*)(ur + 512 + lane * 8);
                float p = h[0] * bflo(a.x) + h[1] * bfhi(a.x) + h[2] * bflo(a.y) + h[3] * bfhi(a.y) + h[4] * bflo(a.z) + h[5] * bfhi(a.z) + h[6] * bflo(a.w) + h[7] * bfhi(a.w);
                p += h[8] * bflo(b.x) + h[9] * bfhi(b.x) + h[10] * bflo(b.y) + h[11] * bfhi(b.y) + h[12] * bflo(b.z) + h[13] * bfhi(b.z) + h[14] * bflo(b.w) + h[15] * bfhi(b.w);
                scr[e * 65 + lane] = p;
            }
            __syncthreads();
            float a = 0.f;
#pragma unroll 16
            for (int l = 0; l < 64; l++) a += scr[lane * 65 + l];
            __syncthreads();
            const float wgt = my_gate * 0.5f * a * (1.f + erff(a * 0.70710678118f));
#pragma unroll 8
            for (int e = 0; e < 64; e++) {
                const int ie = __builtin_amdgcn_readlane(my_idx, e);
                const float we = rl_f(wgt, e);
                const bf16_t* vr = vb + (size_t)ie * DM;
                const u32x4 a4 = *(const u32x4*)(vr + lane * 8), b4 = *(const u32x4*)(vr + 512 + lane * 8);
                acc[0] += we * bflo(a4.x); acc[1] += we * bfhi(a4.x); acc[2] += we * bflo(a4.y); acc[3] += we * bfhi(a4.y);
                acc[4] += we * bflo(a4.z); acc[5] += we * bfhi(a4.z); acc[6] += we * bflo(a4.w); acc[7] += we * bfhi(a4.w);
                acc[8] += we * bflo(b4.x); acc[9] += we * bfhi(b4.x); acc[10] += we * bflo(b4.y); acc[11] += we * bfhi(b4.y);
                acc[12] += we * bflo(b4.z); acc[13] += we * bfhi(b4.z); acc[14] += we * bflo(b4.w); acc[15] += we * bfhi(b4.w);
            }
        }
        if (active) {
            float* xr = xres + (size_t)t * DM;
            f32x4 x0 = *(f32x4*)(xr + lane * 8), x1 = *(f32x4*)(xr + lane * 8 + 4), x2 = *(f32x4*)(xr + 512 + lane * 8), x3 = *(f32x4*)(xr + 512 + lane * 8 + 4);
            x0 += (f32x4){acc[0], acc[1], acc[2], acc[3]}; x1 += (f32x4){acc[4], acc[5], acc[6], acc[7]};
            x2 += (f32x4){acc[8], acc[9], acc[10], acc[11]}; x3 += (f32x4){acc[12], acc[13], acc[14], acc[15]};
            *(f32x4*)(xr + lane * 8) = x0; *(f32x4*)(xr + lane * 8 + 4) = x1; *(f32x4*)(xr + 512 + lane * 8) = x2; *(f32x4*)(xr + 512 + lane * 8 + 4) = x3;
        }
    }
}

constexpr int NPHASES = 27;
constexpr int SMEM_BYTES = 4 * 64 * 65 * 4;
static_assert(SMEM_BYTES >= 2 * 128 * G_LDS * 2 && SMEM_BYTES >= 12352 * 4, "smem");

template <int ph> __device__ __forceinline__ void run_phase(const Params& P, int bid, int nb, unsigned char* smem) {
    unsigned char* ws = P.ws;
    float* smf = (float*)smem; bf16_t* smb = (bf16_t*)smem;
    bf16_t* W_IN = (bf16_t*)(ws + OFF_W_IN); bf16_t* W_OUT = (bf16_t*)(ws + OFF_W_OUT); bf16_t* W_PQ = (bf16_t*)(ws + OFF_W_PQ);
    bf16_t* W_KV = (bf16_t*)(ws + OFF_W_KV); bf16_t* W_Q = (bf16_t*)(ws + OFF_W_Q); bf16_t* W_O = (bf16_t*)(ws + OFF_W_O);
    bf16_t* W_PG = (bf16_t*)(ws + OFF_W_PG); bf16_t* W_PP = (bf16_t*)(ws + OFF_W_PP);
    bf16_t* zx = (bf16_t*)(ws + OFF_Z); float* dtraw = (float*)(ws + OFF_DT); float* ssq = (float*)(ws + OFF_SSQ);
    bf16_t* u_bf = (bf16_t*)(ws + OFF_U); bf16_t* v_bf = (bf16_t*)(ws + OFF_V); bf16_t* p_bf = (bf16_t*)(ws + OFF_P);
    float* xres = (float*)(ws + OFF_XRES); bf16_t* hbuf = (bf16_t*)(ws + OFF_H);
    int* idxb = (int*)(ws + OFF_IDX); float* gateb = (float*)(ws + OFF_GATE);
    bf16_t* kvbuf = (bf16_t*)(ws + OFF_KV); bf16_t* aout = (bf16_t*)(ws + OFF_AO);
    bf16_t* obuf = (bf16_t*)P.out;
    const float* const* in = P.in;
    switch (ph) {
    case 0:
        transpose_convert(in[4], 1024, 6176, 6272, W_IN, bid, nb, smf);
        transpose_convert(in[11], 2048, 1024, 1024, W_OUT, bid, nb, smf);
        transpose_convert(in[22], 1024, 2048, 2048, W_PQ, bid, nb, smf);
        transpose_convert(in[22] + (size_t)1024 * 2048, 1024, 2048, 2048, W_PQ + (size_t)2048 * 1024, bid, nb, smf);
        transpose_convert(in[13], 1024, 256, 256, W_KV, bid, nb, smf);
        transpose_convert(in[16], 1024, 1024, 1024, W_Q, bid, nb, smf);
        transpose_convert(in[19], 1024, 1024, 1024, W_O, bid, nb, smf);
        transpose_convert(in[28], 1024, 1024, 1024, W_PG, bid, nb, smf);
        transpose_convert(in[28] + (size_t)1024 * 1024, 1024, 1024, 1024, W_PG + (size_t)1024 * 1024, bid, nb, smf);
        transpose_convert(in[27], 256, 1024, 1024, W_PP, bid, nb, smf);
        transpose_convert(in[27] + (size_t)256 * 1024, 256, 1024, 1024, W_PP + (size_t)1024 * 256, bid, nb, smf);
        rmsnorm_rows(in[0], in[3], obuf, nullptr, 1e-6f, bid, nb);
        break;
    case 1: gemm_phase(obuf, 1024, W_IN, 1024, T, 6272, 1024, EpiInProj{zx, dtraw}, bid, nb, smb); break;
    case 2: ssd_seq(zx, dtraw, in[5], in[6], in[7], in[8], in[9], obuf, ssq, bid, nb, smf); break;
    case 3:
        ynorm_phase(obuf, ssq, in[10], bid, nb);
        convert_flat(in[24], u_bf, (size_t)2 * 16384 * 1024, bid, nb);
        convert_flat(in[25], v_bf, (size_t)2 * 16384 * 1024, bid, nb);
        convert_flat(in[1], p_bf, (size_t)2 * T * 256, bid, nb);
        break;
    case 4: gemm_phase(obuf, 2048, W_OUT, 2048, T, 1024, 2048, EpiResid{in[0], xres, nullptr}, bid, nb, smb); break;
    case 5: rmsnorm_rows(xres, in[21], hbuf, nullptr, 1e-6f, bid, nb); break;
    case 6: gemm_phase(hbuf, 1024, W_PQ, 1024, T, 2048, 1024, EpiBf16{obuf, 2048, nullptr, 1.f}, bid, nb, smb); break;
    case 7: peer_route(obuf, in[23], idxb, gateb, bid, nb, smf); break;
    case 8: peer_expert(hbuf, u_bf, v_bf, idxb, gateb, xres, bid, nb, smf); break;
    case 9: rmsnorm_rows(xres, in[26], hbuf, nullptr, 1e-6f, bid, nb); break;
    case 10: gemm_phase(p_bf, 256, W_PP, 256, T, 1024, 256, EpiBf16{obuf, 1024, nullptr, 1.f}, bid, nb, smb); break;
    case 11: gemm_phase(hbuf, 1024, W_PG, 1024, T, 1024, 1024, EpiPle{xres, obuf}, bid, nb, smb); break;
    case 12: rmsnorm_rows(xres, in[12], hbuf, nullptr, 1e-6f, bid, nb); break;
    case 13: gemm_phase(hbuf, 1024, W_KV, 1024, T, 256, 1024, EpiBf16{kvbuf, 256, in[14], 1.f}, bid, nb, smb); break;
    case 14: rmsnorm_rows(xres, in[15], hbuf, nullptr, 1e-6f, bid, nb); break;
    case 15: gemm_phase(hbuf, 1024, W_Q, 1024, T, 1024, 1024, EpiBf16{obuf, 1024, in[17], 0.125f}, bid, nb, smb); break;
    case 16: rope_phase(obuf, kvbuf, (const int*)in[2], bid, nb); break;
    case 17: attn_simple(obuf, kvbuf, in[18], aout, bid, nb); break;
    case 18: gemm_phase(aout, 1024, W_O, 1024, T, 1024, 1024, EpiResid{xres, xres, in[20]}, bid, nb, smb); break;
    case 19: rmsnorm_rows(xres, in[21] + 1024, hbuf, nullptr, 1e-6f, bid, nb); break;
    case 20: gemm_phase(hbuf, 1024, W_PQ + (size_t)2048 * 1024, 1024, T, 2048, 1024, EpiBf16{obuf, 2048, nullptr, 1.f}, bid, nb, smb); break;
    case 21: peer_route(obuf, in[23] + 2 * 128 * 128, idxb, gateb, bid, nb, smf); break;
    case 22: peer_expert(hbuf, u_bf + (size_t)16384 * 1024, v_bf + (size_t)16384 * 1024, idxb, gateb, xres, bid, nb, smf); break;
    case 23: rmsnorm_rows(xres, in[26] + 1024, hbuf, nullptr, 1e-6f, bid, nb); break;
    case 24: gemm_phase(p_bf + (size_t)T * 256, 256, W_PP + (size_t)1024 * 256, 256, T, 1024, 256, EpiBf16{obuf, 1024, nullptr, 1.f}, bid, nb, smb); break;
    case 25: gemm_phase(hbuf, 1024, W_PG + (size_t)1024 * 1024, 1024, T, 1024, 1024, EpiPle{xres, obuf}, bid, nb, smb); break;
    case 26: rmsnorm_rows(xres, in[29], nullptr, P.out, 1e-6f, bid, nb); break;
    default: break;
    }
}

template <int ph> __global__ void __launch_bounds__(NTHREADS, 2) k_phase(Params P) {
    __shared__ __attribute__((aligned(16))) unsigned char smem[SMEM_BYTES];
    run_phase<ph>(P, blockIdx.x, gridDim.x, smem);
}
template <int ph> static void launch_phases(const Params& P, hipStream_t stream) {
    if constexpr (ph < NPHASES) {
        const int grid = (ph == 2) ? 256 : 1024;
        hipLaunchKernelGGL(k_phase<ph>, dim3(grid), dim3(NTHREADS), 0, stream, P);
        launch_phases<ph + 1>(P, stream);
    }
}

extern "C" void kernel_launch(void* const* d_in, const int* in_sizes, int n_in, void* d_out, int out_size, void* d_ws, size_t ws_size, hipStream_t stream) {
    if (n_in != 30 || ws_size < WS_END) { fprintf(stderr, "kernel_launch: unexpected n_in %d / ws_size %zu (need %zu)\n", n_in, ws_size, (size_t)WS_END); return; }
    Params P{};
    for (int i = 0; i < 30; i++) P.in[i] = (const float*)d_in[i];
    P.out = (float*)d_out; P.ws = (unsigned char*)d_ws;
    launch_phases<0>(P, stream);
}
```

```cpp
#include <hip/hip_runtime.h>
#include <hip/hip_cooperative_groups.h>
#include <stdint.h>
#include <stdio.h>
namespace cg = cooperative_groups;

typedef unsigned short bf16_t;
typedef short bf16x8 __attribute__((ext_vector_type(8)));
typedef float f32x4 __attribute__((ext_vector_type(4)));
typedef unsigned u32x4 __attribute__((ext_vector_type(4)));
typedef unsigned u32x2 __attribute__((ext_vector_type(2)));
typedef float f32x16 __attribute__((ext_vector_type(16)));

constexpr int T = 32768;
constexpr int SEQ = 4096;
constexpr int DM = 1024;
constexpr int NTHREADS = 512;
constexpr int NW = NTHREADS / 64;

constexpr size_t MiB = 1u << 20;
constexpr size_t OFF_BAR   = 64 * 1024;
constexpr size_t OFF_SCL   = 128 * 1024;
constexpr size_t OFF_W_IN  = 1 * MiB;
constexpr size_t OFF_W_OUT = OFF_W_IN  + (size_t)6400 * 1024 * 2;
constexpr size_t OFF_W_PQ  = OFF_W_OUT + (size_t)1024 * 2048 * 2;
constexpr size_t OFF_W_KV  = OFF_W_PQ  + (size_t)2 * 2048 * 1024 * 2;
constexpr size_t OFF_W_Q   = OFF_W_KV  + (size_t)256 * 1024 * 2;
constexpr size_t OFF_W_O   = OFF_W_Q   + (size_t)1024 * 1024 * 2;
constexpr size_t OFF_W_PG  = OFF_W_O   + (size_t)1024 * 1024 * 2;
constexpr size_t OFF_W_PP  = OFF_W_PG  + (size_t)2 * 1024 * 1024 * 2;
constexpr size_t OFF_W_END = OFF_W_PP  + (size_t)2 * 1024 * 256 * 2;
static_assert(OFF_W_END <= 40 * MiB, "weights region");
constexpr size_t OFF_Z     = 40 * MiB;
constexpr size_t OFF_DT    = OFF_Z + 384 * MiB;
constexpr size_t OFF_SSQ   = OFF_DT + 4 * MiB;
constexpr size_t OFF_U     = OFF_Z;
constexpr size_t OFF_V     = OFF_Z + 64 * MiB;
constexpr size_t OFF_P     = OFF_Z + 128 * MiB;
constexpr size_t OFF_XRES  = OFF_Z + 160 * MiB;
constexpr size_t OFF_H     = OFF_Z + 288 * MiB;
constexpr size_t OFF_IDX   = OFF_Z + 352 * MiB;
constexpr size_t OFF_GATE  = OFF_Z + 368 * MiB;
constexpr size_t OFF_KV    = OFF_Z + 384 * MiB;
constexpr size_t OFF_AO    = OFF_Z + 400 * MiB;
constexpr size_t OFF_SSQP  = OFF_Z + 464 * MiB;
constexpr size_t WS_END    = OFF_Z + 468 * MiB;
static_assert(WS_END <= 512 * MiB, "workspace");

struct Params {
    const float* in[30];
    float* out;
    unsigned char* ws;
};

__device__ __forceinline__ bf16_t f2bf(float f) { unsigned u = __float_as_uint(f); u += 0x7fffu + ((u >> 16) & 1u); return (bf16_t)(u >> 16); }
__device__ __forceinline__ float bf2f(bf16_t h) { return __uint_as_float(((unsigned)h) << 16); }
typedef __bf16 hw_bf16x2 __attribute__((ext_vector_type(2)));
typedef float hw_f32x2 __attribute__((ext_vector_type(2)));
__device__ __forceinline__ unsigned pack2(float lo, float hi) { const hw_f32x2 v = {lo, hi}; return __builtin_bit_cast(unsigned, __builtin_convertvector(v, hw_bf16x2)); }
__device__ __forceinline__ float bflo(unsigned u) { return __uint_as_float(u << 16); }
__device__ __forceinline__ float bfhi(unsigned u) { return __uint_as_float(u & 0xffff0000u); }
template <int X> __device__ __forceinline__ float swz_xor(float v) { return __int_as_float(__builtin_amdgcn_ds_swizzle(__float_as_int(v), 0x1f | (X << 10))); }
__device__ __forceinline__ float bperm(float v, int srclane) { return __int_as_float(__builtin_amdgcn_ds_bpermute(srclane << 2, __float_as_int(v))); }
__device__ __forceinline__ float rl_f(float v, int l) { return __uint_as_float((unsigned)__builtin_amdgcn_readlane((int)__float_as_uint(v), l)); }
template <int N> __device__ __forceinline__ float dpp_row_ror(float v) {
    return __int_as_float(__builtin_amdgcn_update_dpp(0, __float_as_int(v), 0x120 + N, 0xf, 0xf, true));
}
__device__ __forceinline__ float wave_sum(float v) { v += dpp_row_ror<8>(v); v += dpp_row_ror<4>(v); v += dpp_row_ror<2>(v); v += dpp_row_ror<1>(v); return (rl_f(v, 0) + rl_f(v, 16)) + (rl_f(v, 32) + rl_f(v, 48)); }
__device__ __forceinline__ float wave_max(float v) { v = fmaxf(v, dpp_row_ror<8>(v)); v = fmaxf(v, dpp_row_ror<4>(v)); v = fmaxf(v, dpp_row_ror<2>(v)); v = fmaxf(v, dpp_row_ror<1>(v)); return fmaxf(fmaxf(rl_f(v, 0), rl_f(v, 16)), fmaxf(rl_f(v, 32), rl_f(v, 48))); }
__device__ __forceinline__ int opaque_tid(int wv) { int t = (wv << 6) | (int)__builtin_amdgcn_mbcnt_hi(~0u, __builtin_amdgcn_mbcnt_lo(~0u, 0u)); asm volatile("" : "+v"(t)); return t; }
__device__ __forceinline__ float silu_f(float a) { return a * __builtin_amdgcn_rcpf(1.f + __expf(-a)); }

__device__ __forceinline__ void transpose_convert(const float* __restrict__ src, const float* __restrict__ gain, int K, int N, int Npad, bf16_t* __restrict__ dst, int bid, int nb, float* sm, int wv) {
    const int tilesK = K / 64, tid = opaque_tid(wv);
    {
        const int tile = bid; (void)nb; (void)Npad;
        const int tk = tile % tilesK, tn = tile / tilesK, k0 = tk * 64, n0 = tn * 64;
#pragma unroll
        for (int i = 0; i < 2; i++) {
            const int kr = (tid >> 4) + 32 * i, nc = (tid & 15) * 4;
            float4 v = make_float4(0.f, 0.f, 0.f, 0.f);
            if (n0 + nc < N) v = *(const float4*)(src + (size_t)(k0 + kr) * N + n0 + nc);
            if (gain) { const float gk = gain[k0 + kr]; v.x *= gk; v.y *= gk; v.z *= gk; v.w *= gk; }
            sm[kr * 65 + nc + 0] = v.x; sm[kr * 65 + nc + 1] = v.y; sm[kr * 65 + nc + 2] = v.z; sm[kr * 65 + nc + 3] = v.w;
        }
        __syncthreads();
        {
            const int n = tid >> 3, kc = (tid & 7) * 8;
            unsigned o[4];
#pragma unroll
            for (int j = 0; j < 4; j++) o[j] = pack2(sm[(kc + 2 * j) * 65 + n], sm[(kc + 2 * j + 1) * 65 + n]);
            bf16_t* d = dst + (size_t)(n0 + n) * K + k0 + kc;
            *(u32x4*)d = (u32x4){o[0], o[1], o[2], o[3]};
        }
        __syncthreads();
    }
}

__device__ __forceinline__ void convert_flat(const float* __restrict__ src, bf16_t* __restrict__ dst, size_t n, int bid, int nb, int wv) {
    const size_t nvec = n / 8; const int tid = opaque_tid(wv);
    for (size_t i = (size_t)bid * NTHREADS + tid; i < nvec; i += (size_t)nb * NTHREADS) {
        const float4 a = ((const float4*)src)[2 * i], b = ((const float4*)src)[2 * i + 1];
        ((u32x4*)dst)[i] = (u32x4){pack2(a.x, a.y), pack2(a.z, a.w), pack2(b.x, b.y), pack2(b.z, b.w)};
    }
}

typedef float f32x2 __attribute__((ext_vector_type(2)));
constexpr int ROWB = 768;
__device__ __forceinline__ unsigned fp6_code(float x, float inv) {
    const float ax = fminf(fabsf(x) * inv, 7.5f);
    unsigned mag;
    if (ax < 1.f) mag = (unsigned)__float2int_rn(ax * 8.f);
    else { unsigned u = __float_as_uint(ax); u += 0x7FFFFu + ((u >> 20) & 1u); mag = ((((u >> 23) - 127u) + 1u) << 3) | ((u >> 20) & 7u); }
    mag = mag > 31u ? 31u : mag;
    return mag | (x < 0.f ? 32u : 0u);
}
__device__ __forceinline__ void convert_fp6_rows(const float* __restrict__ src, const float* __restrict__ gain  , unsigned char* __restrict__ dst, float* __restrict__ scale, int R, int bid, int nb, int wv) {
    const int tid = opaque_tid(wv), wave = tid >> 6, lane = tid & 63;
    for (int row = bid * NW + wave; row < R; row += nb * NW) {
        const float4* sr = (const float4*)(src + (size_t)row * 1024 + lane * 16);
        float v[16]; float m = 0.f;
#pragma unroll
        for (int i = 0; i < 4; i++) {
            float4 t = sr[i];
            if (gain) { const float4 gg = *(const float4*)(gain + (size_t)(row >> 14) * 1024 + lane * 16 + i * 4); t.x *= gg.x; t.y *= gg.y; t.z *= gg.z; t.w *= gg.w; }
            v[4 * i] = t.x; v[4 * i + 1] = t.y; v[4 * i + 2] = t.z; v[4 * i + 3] = t.w;
            m = fmaxf(m, fmaxf(fmaxf(fabsf(t.x), fabsf(t.y)), fmaxf(fabsf(t.z), fabsf(t.w))));
        }
        m = wave_max(m);
        const float inv = m > 0.f ? 7.5f / m : 0.f;
        unsigned c[16];
#pragma unroll
        for (int j = 0; j < 16; j++) c[j] = fp6_code(v[j], inv);
        const unsigned d0 = c[0] | (c[1] << 6) | (c[2] << 12) | (c[3] << 18) | (c[4] << 24) | (c[5] << 30);
        const unsigned d1 = (c[5] >> 2) | (c[6] << 4) | (c[7] << 10) | (c[8] << 16) | (c[9] << 22) | (c[10] << 28);
        const unsigned d2 = (c[10] >> 4) | (c[11] << 2) | (c[12] << 8) | (c[13] << 14) | (c[14] << 20) | (c[15] << 26);
        unsigned char* rp = dst + (size_t)row * ROWB; const int L = lane >> 1;
        if ((lane & 1) == 0) { unsigned* p = (unsigned*)(rp + L * 16); p[0] = d0; p[1] = d1; p[2] = d2; }
        else { *(unsigned*)(rp + L * 16 + 12) = d0; unsigned* p = (unsigned*)(rp + 512 + L * 8); p[0] = d1; p[1] = d2; }
        if (lane == 0) scale[row] = m * (1.f / 7.5f);
    }
}

__device__ __forceinline__ float row_rscale(const float* __restrict__ ssq, size_t row) {
    const f32x4* p = (const f32x4*)(ssq + row * 16);
    const f32x4 a = p[0], b = p[1], c = p[2], d = p[3];
    const float sum = (((a[0] + a[1]) + (a[2] + a[3])) + ((b[0] + b[1]) + (b[2] + b[3]))) + (((c[0] + c[1]) + (c[2] + c[3])) + ((d[0] + d[1]) + (d[2] + d[3])));
    return rsqrtf(sum * (1.f / DM) + 1e-6f);
}
__device__ __forceinline__ void convert_x_rows(const float* __restrict__ x, bf16_t* __restrict__ xb, float* __restrict__ ssq, int bid, int nb, int wv) {
    const int tid = opaque_tid(wv), wave = tid >> 6, lane = tid & 63;
    for (int row = bid * NW + wave; row < T; row += nb * NW) {
        const float4* xr = (const float4*)(x + (size_t)row * DM);
        float ss = 0.f;
#pragma unroll
        for (int i = 0; i < 4; i++) {
            const float4 v = xr[i * 64 + lane]; ss += v.x * v.x + v.y * v.y + v.z * v.z + v.w * v.w;
            *(u32x2*)(xb + (size_t)row * DM + (i * 64 + lane) * 4) = (u32x2){pack2(v.x, v.y), pack2(v.z, v.w)};
        }
        ss = wave_sum(ss);
        if (lane < 16) ssq[(size_t)row * 16 + lane] = lane == 0 ? ss : 0.f;
    }
}
__device__ __forceinline__ void final_norm_rows(const bf16_t* __restrict__ x, const float* __restrict__ ssq, const float* __restrict__ g, float* __restrict__ out, int bid, int nb, int wv) {
    const int tid = opaque_tid(wv), wave = tid >> 6, lane = tid & 63;
    for (int row = bid * NW + wave; row < T; row += nb * NW) {
        const float r = row_rscale(ssq, (size_t)row);
#pragma unroll
        for (int i = 0; i < 4; i++) {
            const u32x2 xv = *(const u32x2*)(x + (size_t)row * DM + (i * 64 + lane) * 4); const float4 v = make_float4(bflo(xv.x), bfhi(xv.x), bflo(xv.y), bfhi(xv.y)); const float4 gg = ((const float4*)g)[i * 64 + lane];
            ((float4*)(out + (size_t)row * DM))[i * 64 + lane] = make_float4(v.x * r * gg.x, v.y * r * gg.y, v.z * r * gg.z, v.w * r * gg.w);
        }
    }
}

struct RscPre { f32x4 a, b; };
namespace pg8 {
#define PG8_LAS __attribute__((address_space(3)))
typedef unsigned short bf16_t;
typedef short bf16x8 __attribute__((ext_vector_type(8)));
typedef float f32x4 __attribute__((ext_vector_type(4)));
typedef unsigned u32x4 __attribute__((ext_vector_type(4)));
constexpr int BM = 256, BK = 64, HALF = 128, HTB = HALF * BK * 2  , STAGE_BYTES = 8 * HTB, NXCD = 8, WGM = 8;

__host__ __device__ __forceinline__ int lds_byte(int r, int c) { const int st = (r >> 4) * 2 + (c >> 5), rr = r & 15, cc = c & 31, ob = rr * 64 + cc * 2; return st * 1024 + (ob ^ (((ob >> 9) & 1) << 5)); }
__host__ __device__ __forceinline__ void stage_rc(int b, int& R, int& C) { const int st = b / 1024, sb = b % 1024, swz = sb ^ (((sb >> 9) & 1) << 5); R = (st >> 1) * 16 + swz / 64; C = (st & 1) * 32 + (swz % 64) / 2; }
__host__ __device__ __forceinline__ int perm32(int rho) { const int n = rho >> 4, i = rho & 15; return 8 * (i >> 2) + 4 * n + (i & 3); }

struct Unit { int pm, pn; };
struct Gemm { const bf16_t* A; const bf16_t* Bt; int M, N, K; };

struct StaticOrder {
    int nM, nN, nwg, G, c;
    __host__ __device__ void init(int M, int N, int G_, int c_) { nM = M / BM; nN = N / BM; nwg = nM * nN; G = G_; c = c_; }
    __host__ __device__ bool next(int i, Unit& u) const {
        const long L = (long)i * G + c; if (L >= nwg) return false;
        int wgid = (int)L; { const int q = nwg / NXCD, r = nwg % NXCD, xcd = wgid % NXCD, off = wgid / NXCD; wgid = (xcd < r ? xcd * (q + 1) : r * (q + 1) + (xcd - r) * q) + off; }
        const int nig = WGM * nN, gid = wgid / nig, fm = gid * WGM, gsz = (nM - fm) < WGM ? (nM - fm) : WGM;
        u.pm = fm + ((wgid % nig) % gsz); u.pn = (wgid % nig) / gsz; return true;
    }
    __device__ __forceinline__ void a_ready(const Unit&) const {}
    __device__ __forceinline__ void done(const Unit&) const {}
};

template <class Epi, class Sched, bool ALIGN_EPI = false, bool SP2 = false>
__device__ __forceinline__ void gemm_phase(PG8_LAS unsigned char* lds, const Gemm g, const Sched& S, const Epi& E, int wv) {
    const int tid = opaque_tid(wv), wid = __builtin_amdgcn_readfirstlane(tid >> 6), lane = tid & 63, wr = wid >> 2, wc = wid & 3, fr = lane & 15, fq = lane >> 4;
    const int K = g.K, nt = K / BK;
    unsigned voffA[2], voffB[2];
#pragma unroll
    for (int i = 0; i < 2; ++i) { int R, C; stage_rc(tid * 16 + i * 8192, R, C); const int Rb = Epi::PERM ? ((R & ~31) + perm32(R & 31)) : R;
        voffA[i] = (unsigned)(R * K + C) * 2u; voffB[i] = (unsigned)(Rb * K + C) * 2u; }
    const size_t kstep = (size_t)(BK * 2);
    const size_t hstep = (size_t)HALF * K * 2;
    const size_t tstep = 2 * hstep;
    const unsigned ldsw = (unsigned)wid * 1024u;
    const int aoff = lds_byte(wr * 64 + fr, fq * 8), boff = lds_byte(wc * 32 + fr, fq * 8);
#define PG8_SA(b, h) (((b) * 2 + (h)) * HTB)
#define PG8_SB(b, h) ((4 + (b) * 2 + (h)) * HTB)
#define PG8_STAGE(bufoff, gbase, voff) do { _Pragma("unroll") for (int _i = 0; _i < 2; ++_i) \
        __builtin_amdgcn_global_load_lds((const unsigned*)((const char*)(gbase) + (voff)[_i]), (PG8_LAS unsigned*)(lds + (bufoff) + ldsw + _i * 8192), 16, 0, 0); } while (0)
#define PG8_LDA(dst, b, h) do { _Pragma("unroll") for (int m = 0; m < 4; ++m) _Pragma("unroll") for (int k = 0; k < 2; ++k) dst[m][k] = *(const PG8_LAS bf16x8*)(lds + PG8_SA(b, h) + aoff + m * 2048 + k * 1024); } while (0)
#define PG8_LDB(dst, b, h) do { _Pragma("unroll") for (int n = 0; n < 2; ++n) _Pragma("unroll") for (int k = 0; k < 2; ++k) dst[n][k] = *(const PG8_LAS bf16x8*)(lds + PG8_SB(b, h) + boff + n * 2048 + k * 1024); } while (0)
#define PG8_MMA(ai, bj, At, Bt) do { __builtin_amdgcn_s_setprio(1); _Pragma("unroll") for (int m = 0; m < 4; ++m) _Pragma("unroll") for (int n = 0; n < 2; ++n) _Pragma("unroll") for (int k = 0; k < 2; ++k) \
        acc[ai][bj][m][n] = __builtin_amdgcn_mfma_f32_16x16x32_bf16(Bt[n][k], At[m][k], acc[ai][bj][m][n], 0, 0, 0); __builtin_amdgcn_s_setprio(0); } while (0)
#define PG8_WAIT_V(n) asm volatile("s_waitcnt vmcnt(" #n ")" ::: "memory")
#define PG8_WAIT_L(n) asm volatile("s_waitcnt lgkmcnt(" #n ")" ::: "memory")
#define PG8_BAR __builtin_amdgcn_s_barrier()
#define PG8_SCHED __builtin_amdgcn_sched_barrier(0)
    Unit cur, nxt; int ui = 0;
    if (!S.next(0, cur)) return;
    f32x4 acc[2][2][4][2];
#pragma unroll
    for (int a = 0; a < 2; ++a)
#pragma unroll
        for (int b = 0; b < 2; ++b)
#pragma unroll
            for (int m = 0; m < 4; ++m)
#pragma unroll
                for (int n = 0; n < 2; ++n) acc[a][b][m][n] = (f32x4){0.f, 0.f, 0.f, 0.f};
    bf16x8 At[4][2], B0[2][2], B1[2][2];
    const char* cA = (const char*)g.A + (size_t)cur.pm * tstep; const char* cB = (const char*)g.Bt + (size_t)cur.pn * tstep;
    S.a_ready(cur);
    PG8_LAS float* rtab0 = (PG8_LAS float*)(lds + STAGE_BYTES + 8192);
    if constexpr (Epi::RSCALE) { const int t_ = opaque_tid(wv); const RscPre p_ = E.rissue(cur, t_); E.rfinish(p_, rtab0, t_); }
    if constexpr (Epi::KSCALE) E.kfill(lds + STAGE_BYTES, cur, opaque_tid(wv));
    if constexpr (SP2) {
        PG8_STAGE(PG8_SB(0, 0), cB, voffB); PG8_STAGE(PG8_SB(0, 1), cB + hstep, voffB); PG8_STAGE(PG8_SA(0, 0), cA, voffA); PG8_STAGE(PG8_SA(0, 1), cA + hstep, voffA);
        if (wr == 1) PG8_BAR;
        PG8_WAIT_V(2); PG8_BAR;
        PG8_STAGE(PG8_SB(1, 0), cB + kstep, voffB); PG8_STAGE(PG8_SA(1, 0), cA + kstep, voffA); PG8_STAGE(PG8_SB(1, 1), cB + hstep + kstep, voffB);
        PG8_WAIT_V(6); PG8_BAR;
    } else {
        PG8_STAGE(PG8_SB(0, 0), cB, voffB); PG8_STAGE(PG8_SA(0, 0), cA, voffA); PG8_STAGE(PG8_SB(0, 1), cB + hstep, voffB); PG8_STAGE(PG8_SA(0, 1), cA + hstep, voffA);
        if (wr == 1) PG8_BAR;
        PG8_WAIT_V(4); PG8_BAR;
        PG8_STAGE(PG8_SB(1, 0), cB + kstep, voffB); PG8_STAGE(PG8_SA(1, 0), cA + kstep, voffA); PG8_STAGE(PG8_SB(1, 1), cB + hstep + kstep, voffB);
        PG8_WAIT_V(6); PG8_BAR;
    }
    for (;;) {
        const bool has_next = S.next(ui + 1, nxt);
        const char* nA = has_next ? (const char*)g.A + (size_t)nxt.pm * tstep : cA; const char* nB = has_next ? (const char*)g.Bt + (size_t)nxt.pn * tstep : cB;
#pragma unroll 1
        for (int t = 0; t < nt; t += 2) {
            const bool last = (t == nt - 2);
            const char* a1 = cA + (size_t)(t + 1) * kstep;
            const char* a2 = last ? nA : cA + (size_t)(t + 2) * kstep; const char* b2 = last ? nB : cB + (size_t)(t + 2) * kstep;
            const char* a3 = a2 + kstep; const char* b3 = b2 + kstep;
            if (last && has_next) S.a_ready(nxt);
            if constexpr (Epi::KSCALE) { if ((t & 3) == 0 && t > 0) {
                const int gq = (t >> 2) - 1;
                PG8_LAS const unsigned char* qb_ = lds + STAGE_BYTES + (gq * 256 + wr * 64 + (opaque_tid(wv) & 15)) * 4;
#pragma unroll
                for (int ai = 0; ai < 2; ++ai)
#pragma unroll
                    for (int m = 0; m < 4; ++m) {
                        const float q = *(const PG8_LAS float*)(qb_ + (ai * 128 + m * 16) * 4);
#pragma unroll
                        for (int bj = 0; bj < 2; ++bj)
#pragma unroll
                            for (int n = 0; n < 2; ++n) acc[ai][bj][m][n] *= q;
                        asm volatile("" ::: "memory");
                    }
            } }
            if constexpr (SP2) {
            PG8_LDB(B0, 0, 0); PG8_LDB(B1, 0, 1); PG8_SCHED; PG8_LDA(At, 0, 0); PG8_STAGE(PG8_SA(1, 1), a1 + hstep, voffA);
            PG8_WAIT_V(8); PG8_WAIT_L(0); PG8_BAR; PG8_MMA(0, 0, At, B0); PG8_MMA(0, 1, At, B1); PG8_BAR; PG8_SCHED;
            PG8_LDA(At, 0, 1); PG8_STAGE(PG8_SB(0, 0), b2, voffB); PG8_STAGE(PG8_SB(0, 1), b2 + hstep, voffB); PG8_STAGE(PG8_SA(0, 0), a2, voffA);
            PG8_WAIT_V(8); PG8_WAIT_L(0); PG8_BAR; PG8_MMA(1, 0, At, B0); PG8_MMA(1, 1, At, B1); PG8_BAR; PG8_SCHED;
            PG8_LDB(B0, 1, 0); PG8_LDB(B1, 1, 1); PG8_SCHED; PG8_LDA(At, 1, 0); PG8_STAGE(PG8_SA(0, 1), a2 + hstep, voffA);
            PG8_WAIT_V(8); PG8_WAIT_L(0); PG8_BAR; PG8_MMA(0, 0, At, B0); PG8_MMA(0, 1, At, B1); PG8_BAR; PG8_SCHED;
            PG8_LDA(At, 1, 1); PG8_STAGE(PG8_SB(1, 0), b3, voffB); PG8_STAGE(PG8_SB(1, 1), b3 + hstep, voffB); PG8_STAGE(PG8_SA(1, 0), a3, voffA);
            PG8_WAIT_V(8); PG8_WAIT_L(0); PG8_BAR; PG8_MMA(1, 0, At, B0); PG8_MMA(1, 1, At, B1); PG8_BAR; PG8_SCHED;
            } else {
            PG8_LDB(B0, 0, 0); PG8_SCHED; PG8_LDA(At, 0, 0); PG8_STAGE(PG8_SA(1, 1), a1 + hstep, voffA);
            PG8_WAIT_L(8); PG8_BAR; PG8_WAIT_L(0); PG8_MMA(0, 0, At, B0); PG8_BAR; PG8_SCHED;
            PG8_LDB(B1, 0, 1); PG8_STAGE(PG8_SB(0, 0), b2, voffB);
            PG8_BAR; PG8_WAIT_L(0); PG8_MMA(0, 1, At, B1); PG8_BAR;
            PG8_LDA(At, 0, 1); PG8_STAGE(PG8_SA(0, 0), a2, voffA);
            PG8_BAR; PG8_WAIT_L(0); PG8_MMA(1, 0, At, B0); PG8_BAR; PG8_SCHED;
            PG8_STAGE(PG8_SB(0, 1), b2 + hstep, voffB);
            PG8_WAIT_V(6); PG8_BAR; PG8_MMA(1, 1, At, B1); PG8_BAR;
            PG8_LDB(B0, 1, 0); PG8_SCHED; PG8_LDA(At, 1, 0); PG8_STAGE(PG8_SA(0, 1), a2 + hstep, voffA);
            PG8_WAIT_L(8); PG8_BAR; PG8_WAIT_L(0); PG8_MMA(0, 0, At, B0); PG8_BAR; PG8_SCHED;
            PG8_LDB(B1, 1, 1); PG8_STAGE(PG8_SB(1, 0), b3, voffB);
            PG8_BAR; PG8_WAIT_L(0); PG8_MMA(0, 1, At, B1); PG8_BAR;
            PG8_LDA(At, 1, 1); PG8_STAGE(PG8_SA(1, 0), a3, voffA);
            PG8_BAR; PG8_WAIT_L(0); PG8_MMA(1, 0, At, B0); PG8_BAR; PG8_SCHED;
            PG8_STAGE(PG8_SB(1, 1), b3 + hstep, voffB);
            PG8_WAIT_V(6); PG8_BAR; PG8_MMA(1, 1, At, B1); PG8_BAR;
            }
        }
        if constexpr (Epi::KSCALE) {
            PG8_LAS const unsigned char* qb_ = lds + STAGE_BYTES + (((nt >> 2) - 1) * 256 + wr * 64 + (opaque_tid(wv) & 15)) * 4;
#pragma unroll
            for (int ai = 0; ai < 2; ++ai)
#pragma unroll
                for (int m = 0; m < 4; ++m) {
                    const float q = *(const PG8_LAS float*)(qb_ + (ai * 128 + m * 16) * 4);
#pragma unroll
                    for (int bj = 0; bj < 2; ++bj)
#pragma unroll
                        for (int n = 0; n < 2; ++n) acc[ai][bj][m][n] *= q;
                    asm volatile("" ::: "memory");
                }
        }
        if constexpr (ALIGN_EPI) { if (wr == 0) PG8_BAR; }
        RscPre rpre_; rpre_.a = rpre_.b = (f32x4){0.f, 0.f, 0.f, 0.f};
        if constexpr (Epi::RSCALE) { if (has_next) rpre_ = E.rissue(nxt, opaque_tid(wv)); }
        if constexpr (!Epi::AFTER_DRAIN) { E(acc, cur, wr, wc, fr, fq, rtab0 + (ui & 1) * 256); S.done(cur); }
        if constexpr (Epi::RSCALE) { if (has_next) E.rfinish(rpre_, rtab0 + ((ui + 1) & 1) * 256, opaque_tid(wv)); }
        if constexpr (Epi::KSCALE) { if (has_next) E.kfill(lds + STAGE_BYTES, nxt, opaque_tid(wv)); }
        if (!has_next) break;
#pragma unroll
        for (int a = 0; a < 2; ++a)
#pragma unroll
            for (int b = 0; b < 2; ++b)
#pragma unroll
                for (int m = 0; m < 4; ++m)
#pragma unroll
                    for (int n = 0; n < 2; ++n) acc[a][b][m][n] = (f32x4){0.f, 0.f, 0.f, 0.f};
        cur = nxt; cA = nA; cB = nB; ++ui;
        if constexpr (ALIGN_EPI) { if (wr == 1) PG8_BAR; }
    }
    PG8_WAIT_V(0);
    if constexpr (!ALIGN_EPI) { if (wr == 0) PG8_BAR; }
    PG8_BAR;
    if constexpr (Epi::AFTER_DRAIN) { E.fused(acc, cur, wr, wc, fr, fq, lds, wid, lane); S.done(cur); }
#undef PG8_SA
#undef PG8_SB
#undef PG8_STAGE
#undef PG8_LDA
#undef PG8_LDB
#undef PG8_MMA
#undef PG8_WAIT_V
#undef PG8_WAIT_L
#undef PG8_BAR
#undef PG8_SCHED
}
}

typedef pg8::Unit GUnit;
#ifndef GEMM_SP2
#define GEMM_SP2 true
#endif
struct PRef { int kind; long off; };
#define PR_NUL (PRef{-2, 0})
#define PR_WS(off_) (PRef{-1, (long)(off_)})
#define PR_OUT(off_) (PRef{-3, (long)(off_)})
#define PR_IN(k_, off_) (PRef{(k_), (long)(off_)})
__device__ __forceinline__ int opaque_zero() { int z; asm volatile("s_mov_b32 %0, 0" : "=s"(z)); return z; }
template <class Tp> __device__ __forceinline__ Tp* pr_resolve(const Params& P, const PRef r, int z) {
    if (r.kind == -2) return (Tp*)nullptr;
    if (r.kind == -1) return (Tp*)((&P.ws)[z] + r.off);
    if (r.kind == -3) return (Tp*)((unsigned char*)((&P.out)[z]) + r.off);
    return (Tp*)((const unsigned char*)(P.in[r.kind + z]) + r.off);
}
#define EPI_ROWS_BEGIN const int row0 = u.pm * 256 + wr * 64 + fr, col00 = u.pn * 256 + wc * 32 + 8 * fq; \
    _Pragma("unroll") for (int ai = 0; ai < 2; ++ai) _Pragma("unroll") for (int m = 0; m < 4; ++m) { const size_t row = (size_t)(row0 + ai * 128 + m * 16); asm volatile("" ::: "memory");
#define EPI_ROWS_END }
__device__ __forceinline__ RscPre rsc_issue(const Params& P, const PRef ssq_in_, const GUnit& u, int tid) {
    const float* ssq_in = pr_resolve<const float>(P, ssq_in_, opaque_zero());
    RscPre p; p.a = p.b = (f32x4){0.f, 0.f, 0.f, 0.f};
    if (ssq_in) { const float* q = ssq_in + (size_t)(u.pm * 256 + (tid >> 1)) * 16 + (tid & 1) * 8; p.a = *(const f32x4*)q; p.b = *(const f32x4*)(q + 4); }
    return p;
}
__device__ __forceinline__ void rsc_finish(const RscPre& p, bool have, PG8_LAS float* tab, int tid) {
    float s_ = ((p.a[0] + p.a[1]) + (p.a[2] + p.a[3])) + ((p.b[0] + p.b[1]) + (p.b[2] + p.b[3]));
    s_ += __int_as_float(__builtin_amdgcn_update_dpp(0, __float_as_int(s_), 0xB1  , 0xf, 0xf, true));
    if (!(tid & 1)) tab[tid >> 1] = have ? rsqrtf(s_ * (1.f / DM) + 1e-6f) : 1.f;
}
#define EPI_ROW_SCALES(ssq_in) float rr_[2][4]; \
    _Pragma("unroll") for (int ai = 0; ai < 2; ++ai) _Pragma("unroll") for (int m = 0; m < 4; ++m) rr_[ai][m] = rtab[ai * 128 + wr * 64 + m * 16 + fr];
#define EPI_SSQ_STORE(ssq_out, sq) do { float s_ = (sq); s_ += swz_xor<16>(s_); s_ += bperm(s_, (fq * 16 + fr) ^ 32); if (fq == 0) (ssq_out)[row * 16 + u.pn * 4 + wc] = s_; } while (0)
struct EpiInProj {
    static constexpr bool PERM = true, AFTER_DRAIN = false, KSCALE = false;
    static constexpr bool RSCALE = true;
    __device__ __forceinline__ RscPre rissue(const GUnit& u, int tid) const { return rsc_issue(*P, ssq_in_, u, tid); }
    __device__ __forceinline__ void rfinish(const RscPre& p, PG8_LAS float* tab, int tid) const { rsc_finish(p, ssq_in_.kind != -2, tab, tid); }
    const Params* P; PRef zx_, dtraw_, ssq_in_;
    __device__ __forceinline__ void operator()(const f32x4 (&acc)[2][2][4][2], const GUnit& u, int wr, int wc, int fr, int fq, const PG8_LAS float* rtab) const {
        const int z = opaque_zero(); bf16_t* zx = pr_resolve<bf16_t>(*P, zx_, z); float* dtraw = pr_resolve<float>(*P, dtraw_, z); const float* ssq_in = pr_resolve<const float>(*P, ssq_in_, z);
        EPI_ROW_SCALES(ssq_in)
        EPI_ROWS_BEGIN
            const float r = rr_[ai][m];
#pragma unroll
            for (int bj = 0; bj < 2; ++bj) {
                const int col = col00 + bj * 128; const f32x4 v0 = acc[ai][bj][m][0] * r, v1 = acc[ai][bj][m][1] * r;
                if (col < 6144) *(u32x4*)(zx + row * 6144 + col) = (u32x4){pack2(v0[0], v0[1]), pack2(v0[2], v0[3]), pack2(v1[0], v1[1]), pack2(v1[2], v1[3])};
                else if (col < 6176) { *(f32x4*)(dtraw + row * 32 + (col - 6144)) = v0; *(f32x4*)(dtraw + row * 32 + (col - 6144) + 4) = v1; }
            }
        EPI_ROWS_END
    }
};
struct EpiResid {
    static constexpr bool PERM = true, AFTER_DRAIN = false, KSCALE = false;
    static constexpr bool RSCALE = false;
    const Params* P; PRef resid32_, residb_, bias_, xb_, ssq_out_;
    __device__ __forceinline__ void operator()(const f32x4 (&acc)[2][2][4][2], const GUnit& u, int wr, int wc, int fr, int fq, const PG8_LAS float* rtab) const {
        const int z = opaque_zero(); const float* resid32 = pr_resolve<const float>(*P, resid32_, z); const bf16_t* residb = pr_resolve<const bf16_t>(*P, residb_, z); const float* bias = pr_resolve<const float>(*P, bias_, z);
        bf16_t* xb = pr_resolve<bf16_t>(*P, xb_, z); float* ssq_out = pr_resolve<float>(*P, ssq_out_, z);
        f32x4 nrs[2][2];
        f32x4 bv_[2][2];
        { const int row0_ = u.pm * 256 + wr * 64 + fr, col0_ = u.pn * 256 + wc * 32 + 8 * fq;
#pragma unroll
          for (int bj = 0; bj < 2; ++bj) {
              if (bias) { bv_[bj][0] = *(const f32x4*)(bias + col0_ + bj * 128); bv_[bj][1] = *(const f32x4*)(bias + col0_ + bj * 128 + 4); } else { bv_[bj][0] = bv_[bj][1] = (f32x4){0.f, 0.f, 0.f, 0.f}; }
              if (resid32) { nrs[bj][0] = *(const f32x4*)(resid32 + (size_t)row0_ * DM + col0_ + bj * 128); nrs[bj][1] = *(const f32x4*)(resid32 + (size_t)row0_ * DM + col0_ + bj * 128 + 4); }
              else { nrs[bj][0] = __builtin_bit_cast(f32x4, *(const u32x4*)(residb + (size_t)row0_ * DM + col0_ + bj * 128)); nrs[bj][1] = nrs[bj][0]; } } }
        EPI_ROWS_BEGIN
            float sq = 0.f;
            const f32x4 crs[2][2] = {{nrs[0][0], nrs[0][1]}, {nrs[1][0], nrs[1][1]}};
            if (ai * 4 + m < 7) { const size_t rn = (size_t)(row0 + ((ai * 4 + m + 1) >> 2) * 128 + ((ai * 4 + m + 1) & 3) * 16);
#pragma unroll
                for (int bj = 0; bj < 2; ++bj) {
                    if (resid32) { nrs[bj][0] = *(const f32x4*)(resid32 + rn * DM + col00 + bj * 128); nrs[bj][1] = *(const f32x4*)(resid32 + rn * DM + col00 + bj * 128 + 4); }
                    else { nrs[bj][0] = __builtin_bit_cast(f32x4, *(const u32x4*)(residb + rn * DM + col00 + bj * 128)); } } }
            asm volatile("" ::: "memory");
#pragma unroll
            for (int bj = 0; bj < 2; ++bj) {
                const int col = col00 + bj * 128; f32x4 v0 = acc[ai][bj][m][0], v1 = acc[ai][bj][m][1];
                v0 += bv_[bj][0]; v1 += bv_[bj][1];
                if (resid32) { v0 += crs[bj][0]; v1 += crs[bj][1]; }
                else { const u32x4 rb = __builtin_bit_cast(u32x4, crs[bj][0]);
                       v0 += (f32x4){bflo(rb.x), bfhi(rb.x), bflo(rb.y), bfhi(rb.y)}; v1 += (f32x4){bflo(rb.z), bfhi(rb.z), bflo(rb.w), bfhi(rb.w)}; }
                *(u32x4*)(xb + row * DM + col) = (u32x4){pack2(v0[0], v0[1]), pack2(v0[2], v0[3]), pack2(v1[0], v1[1]), pack2(v1[2], v1[3])};
                sq += (v0[0] * v0[0] + v0[1] * v0[1]) + (v0[2] * v0[2] + v0[3] * v0[3]) + (v1[0] * v1[0] + v1[1] * v1[1]) + (v1[2] * v1[2] + v1[3] * v1[3]);
                asm volatile("" ::: "memory");
            }
            EPI_SSQ_STORE(ssq_out, sq);
        EPI_ROWS_END
    }
};
struct EpiResidY : EpiResid {
    static constexpr bool KSCALE = true;
    PRef ssqh_;
    __device__ __forceinline__ void kfill(PG8_LAS unsigned char* tab, const GUnit& u, int tid) const {
        const float* ssqh = pr_resolve<const float>(*P, ssqh_, opaque_zero());
        const int lr = tid & 255, hf = tid >> 8;
        const float* sp = ssqh + (size_t)(u.pm * 256 + lr) * 32 + hf * 16;
        float r[5];
#pragma unroll
        for (int g = 0; g < 5; g++) {
            const f32x4 s4 = *(const f32x4*)(sp + ((hf == 1 && g == 4) ? 12 : g * 4));
            r[g] = rsqrtf((s4[0] + s4[1] + s4[2] + s4[3]) * (1.f / 256.f) + 1e-5f);
        }
#pragma unroll
        for (int g = 0; g < 4; g++) {
            const float q = (hf == 1 && g == 3) ? r[3] : r[g] / r[g + 1];
            *(PG8_LAS float*)(tab + ((hf * 4 + g) * 256 + lr) * 4) = q;
        }
    }
};
struct EpiBf16 {
    static constexpr bool PERM = true, AFTER_DRAIN = false, KSCALE = false;
    static constexpr bool RSCALE = true;
    __device__ __forceinline__ RscPre rissue(const GUnit& u, int tid) const { return rsc_issue(*P, ssq_in_, u, tid); }
    __device__ __forceinline__ void rfinish(const RscPre& p, PG8_LAS float* tab, int tid) const { rsc_finish(p, ssq_in_.kind != -2, tab, tid); }
    const Params* P; PRef out_; int ldc; PRef bias_; float scale; PRef ssq_in_;
    __device__ __forceinline__ void operator()(const f32x4 (&acc)[2][2][4][2], const GUnit& u, int wr, int wc, int fr, int fq, const PG8_LAS float* rtab) const {
        const int z = opaque_zero(); bf16_t* out = pr_resolve<bf16_t>(*P, out_, z); const float* bias = pr_resolve<const float>(*P, bias_, z); const float* ssq_in = pr_resolve<const float>(*P, ssq_in_, z);
        EPI_ROW_SCALES(ssq_in)
        EPI_ROWS_BEGIN
            const float r = rr_[ai][m];
#pragma unroll
            for (int bj = 0; bj < 2; ++bj) {
                const int col = col00 + bj * 128; f32x4 v0 = acc[ai][bj][m][0] * r, v1 = acc[ai][bj][m][1] * r;
                if (bias) { v0 += *(const f32x4*)(bias + col); v1 += *(const f32x4*)(bias + col + 4); }
                v0 *= scale; v1 *= scale;
                *(u32x4*)(out + row * ldc + col) = (u32x4){pack2(v0[0], v0[1]), pack2(v0[2], v0[3]), pack2(v1[0], v1[1]), pack2(v1[2], v1[3])};
            }
        EPI_ROWS_END
    }
};
struct EpiKVQ {
    static constexpr bool PERM = true, AFTER_DRAIN = false, KSCALE = false;
    static constexpr bool RSCALE = true;
    __device__ __forceinline__ RscPre rissue(const GUnit& u, int tid) const { return rsc_issue(*P, ssq_in_, u, tid); }
    __device__ __forceinline__ void rfinish(const RscPre& p, PG8_LAS float* tab, int tid) const { rsc_finish(p, ssq_in_.kind != -2, tab, tid); }
    const Params* P; PRef kvbuf_, qatt_, kv_b_, q_b_, ssq_in_;
    __device__ __forceinline__ void operator()(const f32x4 (&acc)[2][2][4][2], const GUnit& u, int wr, int wc, int fr, int fq, const PG8_LAS float* rtab) const {
        const int z = opaque_zero(); bf16_t* kvbuf = pr_resolve<bf16_t>(*P, kvbuf_, z); bf16_t* qatt = pr_resolve<bf16_t>(*P, qatt_, z);
        const float* kv_b = pr_resolve<const float>(*P, kv_b_, z); const float* q_b = pr_resolve<const float>(*P, q_b_, z); const float* ssq_in = pr_resolve<const float>(*P, ssq_in_, z);
        const bool isq = u.pn > 0;
        const float* bias = isq ? q_b - 256 : kv_b; bf16_t* outp = isq ? qatt - 256 : kvbuf; const int ldc = isq ? 1024 : 256; const float scale = isq ? 0.125f : 1.f;
        EPI_ROW_SCALES(ssq_in)
        f32x4 bv_[2][2];
        { const int col0_ = u.pn * 256 + wc * 32 + 8 * fq;
#pragma unroll
          for (int bj = 0; bj < 2; ++bj) { bv_[bj][0] = *(const f32x4*)(bias + col0_ + bj * 128); bv_[bj][1] = *(const f32x4*)(bias + col0_ + bj * 128 + 4); } }
        EPI_ROWS_BEGIN
            const float r = rr_[ai][m];
#pragma unroll
            for (int bj = 0; bj < 2; ++bj) {
                const int col = col00 + bj * 128; f32x4 v0 = acc[ai][bj][m][0] * r, v1 = acc[ai][bj][m][1] * r;
                v0 += bv_[bj][0]; v1 += bv_[bj][1];
                v0 *= scale; v1 *= scale;
                *(u32x4*)(outp + row * ldc + col) = (u32x4){pack2(v0[0], v0[1]), pack2(v0[2], v0[3]), pack2(v1[0], v1[1]), pack2(v1[2], v1[3])};
            }
        EPI_ROWS_END
    }
};
struct EpiPle {
    static constexpr bool PERM = true, AFTER_DRAIN = false, KSCALE = false;
    static constexpr bool RSCALE = true;
    __device__ __forceinline__ RscPre rissue(const GUnit& u, int tid) const { return rsc_issue(*P, ssq_in_, u, tid); }
    __device__ __forceinline__ void rfinish(const RscPre& p, PG8_LAS float* tab, int tid) const { rsc_finish(p, ssq_in_.kind != -2, tab, tid); }
    const Params* P; PRef xin_, tmp_, ssq_in_, xb_, ssq_out_;
    __device__ __forceinline__ void operator()(const f32x4 (&acc)[2][2][4][2], const GUnit& u, int wr, int wc, int fr, int fq, const PG8_LAS float* rtab) const {
        const int z = opaque_zero(); const bf16_t* xin = pr_resolve<const bf16_t>(*P, xin_, z); const bf16_t* tmp = pr_resolve<const bf16_t>(*P, tmp_, z); const float* ssq_in = pr_resolve<const float>(*P, ssq_in_, z);
        bf16_t* xb = pr_resolve<bf16_t>(*P, xb_, z); float* ssq_out = pr_resolve<float>(*P, ssq_out_, z);
        EPI_ROW_SCALES(ssq_in)
        u32x4 ntb, nxb;
        { const int row0_ = u.pm * 256 + wr * 64 + fr, col0_ = u.pn * 256 + wc * 32 + 8 * fq;
          ntb = *(const u32x4*)(tmp + (size_t)row0_ * DM + col0_); nxb = *(const u32x4*)(xin + (size_t)row0_ * DM + col0_); }
        EPI_ROWS_BEGIN
            const float r = rr_[ai][m];
            float sq = 0.f;
#pragma unroll
            for (int bj = 0; bj < 2; ++bj) {
                const int col = col00 + bj * 128; const f32x4 v0 = acc[ai][bj][m][0] * r, v1 = acc[ai][bj][m][1] * r;
                const u32x4 tb = ntb; const u32x4 xbv = nxb;
                { const int jn = (ai * 4 + m) * 2 + bj + 1;
                  if (jn < 16) { const size_t rn = (size_t)(row0 + ((jn >> 1) >> 2) * 128 + ((jn >> 1) & 3) * 16); const int cn = col00 + (jn & 1) * 128;
                                 ntb = *(const u32x4*)(tmp + rn * DM + cn); nxb = *(const u32x4*)(xin + rn * DM + cn); } }
                asm volatile("" ::: "memory");
                f32x4 x0 = (f32x4){bflo(xbv.x), bfhi(xbv.x), bflo(xbv.y), bfhi(xbv.y)}, x1 = (f32x4){bflo(xbv.z), bfhi(xbv.z), bflo(xbv.w), bfhi(xbv.w)};
                x0[0] += bflo(tb.x) * __builtin_amdgcn_rcpf(1.f + __expf(-v0[0])); x0[1] += bfhi(tb.x) * __builtin_amdgcn_rcpf(1.f + __expf(-v0[1]));
                x0[2] += bflo(tb.y) * __builtin_amdgcn_rcpf(1.f + __expf(-v0[2])); x0[3] += bfhi(tb.y) * __builtin_amdgcn_rcpf(1.f + __expf(-v0[3]));
                x1[0] += bflo(tb.z) * __builtin_amdgcn_rcpf(1.f + __expf(-v1[0])); x1[1] += bfhi(tb.z) * __builtin_amdgcn_rcpf(1.f + __expf(-v1[1]));
                x1[2] += bflo(tb.w) * __builtin_amdgcn_rcpf(1.f + __expf(-v1[2])); x1[3] += bfhi(tb.w) * __builtin_amdgcn_rcpf(1.f + __expf(-v1[3]));
                *(u32x4*)(xb + row * DM + col) = (u32x4){pack2(x0[0], x0[1]), pack2(x0[2], x0[3]), pack2(x1[0], x1[1]), pack2(x1[2], x1[3])};
                sq += (x0[0] * x0[0] + x0[1] * x0[1]) + (x0[2] * x0[2] + x0[3] * x0[3]) + (x1[0] * x1[0] + x1[1] * x1[1]) + (x1[2] * x1[2] + x1[3] * x1[3]);
                asm volatile("" ::: "memory");
            }
            EPI_SSQ_STORE(ssq_out, sq);
        EPI_ROWS_END
    }
};
template <class Epi>
__device__ __forceinline__ void gemm_phase(const bf16_t* A, int lda, const bf16_t* Bt, int ldb, int M, int N, int K, const Epi& epi, int bid, int nb, bf16_t* sm, int wv) {
    pg8::Gemm g{A, Bt, M, N, K};
    pg8::StaticOrder S; S.init(M, N, nb, bid);
    pg8::gemm_phase<Epi, pg8::StaticOrder, true, GEMM_SP2>((PG8_LAS unsigned char*)sm, g, S, epi, wv);
    __syncthreads();
}

constexpr int S_LC = 136, S_LT = 72;
constexpr int SSD_OFF_C = 0, SSD_OFF_B = SSD_OFF_C + 64 * S_LC * 2, SSD_OFF_BT = SSD_OFF_B + 64 * S_LC * 2, SSD_OFF_XD = SSD_OFF_BT + 128 * S_LT * 2,
              SSD_OFF_XDD = SSD_OFF_XD + 64 * S_LT * 2, SSD_OFF_M = SSD_OFF_XDD + 64 * S_LT * 2, SSD_OFF_F = SSD_OFF_M + 64 * S_LT * 2, SSD_OFF_CW = SSD_OFF_F + (2 * 5 * 64 + 4 * 64) * 4, SSD_SMEM = SSD_OFF_CW + 40 * 41 * 4;
template <int N> __device__ __forceinline__ float dpp_row_shr0(float v) {
    return __int_as_float(__builtin_amdgcn_update_dpp(0, __float_as_int(v), 0x110 + N, 0xf, 0xf, false));
}
#define SSD_FILL_F(dst, chunk_) do { float* d_ = (dst); const float v_ = dtv_next + dtb; const float e_ = __expf(-fabsf(v_)); \
    const float dt_ = fmaxf(v_, 0.f) + (e_ < 0.001f ? e_ * (1.f - 0.5f * e_) : __logf(1.f + e_)); float cs_ = dt_ * Aneg; \
    cs_ += dpp_row_shr0<1>(cs_); cs_ += dpp_row_shr0<2>(cs_); cs_ += dpp_row_shr0<4>(cs_); cs_ += dpp_row_shr0<8>(cs_); \
    { const float r0_ = rl_f(cs_, 15), r1_ = rl_f(cs_, 31), r2_ = rl_f(cs_, 47); cs_ += ((lane >= 16 ? r0_ : 0.f) + (lane >= 32 ? r1_ : 0.f)) + (lane >= 48 ? r2_ : 0.f); } \
    const float cl_ = rl_f(cs_, 63); d_[lane] = dt_; d_[64 + lane] = cs_; d_[128 + lane] = __expf(cs_); d_[192 + lane] = __expf(cl_ - cs_); d_[256 + lane] = 1.f / dt_; } while (0)
__device__ __forceinline__ float elem8(const u32x4& v, int c) { const unsigned u = c < 2 ? v.x : c < 4 ? v.y : c < 6 ? v.z : v.w; return (c & 1) ? bfhi(u) : bflo(u); }
__device__ __forceinline__ void dt_minigemm(const bf16_t* __restrict__ xb, const bf16_t* __restrict__ wt, const float* __restrict__ ssq_in, float* __restrict__ dtraw, int bid, int nb, int wv) {
    const int tid = opaque_tid(wv), w = tid >> 6, lane = tid & 63, l15 = lane & 15, quad = lane >> 4;
    for (int grp = bid * NW + w; grp < T / 16; grp += nb * NW) {
        const bf16_t* ap = xb + (size_t)(grp * 16 + l15) * DM + quad * 8;
        const bf16_t* bp = wt + (size_t)l15 * DM + quad * 8;
        f32x4 acc0 = (f32x4){0.f, 0.f, 0.f, 0.f}, acc1 = acc0;
#pragma unroll 8
        for (int s = 0; s < 32; s++) {
            const bf16x8 a = *(const bf16x8*)(ap + s * 32), b0 = *(const bf16x8*)(bp + s * 32), b1 = *(const bf16x8*)(bp + 16 * DM + s * 32);
            acc0 = __builtin_amdgcn_mfma_f32_16x16x32_bf16(a, b0, acc0, 0, 0, 0);
            acc1 = __builtin_amdgcn_mfma_f32_16x16x32_bf16(a, b1, acc1, 0, 0, 0);
        }
#pragma unroll
        for (int i = 0; i < 4; i++) {
            const size_t row = (size_t)grp * 16 + quad * 4 + i;
            const float r = row_rscale(ssq_in, row);
            dtraw[row * 32 + l15] = acc0[i] * r; dtraw[row * 32 + 16 + l15] = acc1[i] * r;
        }
    }
}
struct BcHalo { u32x4 r0, r1, r2; };
__device__ __forceinline__ int bc_nseg(int nb) { int n = 64; while (n > 1 && 8 * n * 256 > nb * NTHREADS) n >>= 1; return n; }
__device__ __forceinline__ BcHalo bc_preact_halo(const bf16_t* zx, int bid, int nb, int wv) {
    const int gt = bid * NTHREADS + opaque_tid(wv), nseg = bc_nseg(nb), seglen = SEQ / nseg;
    BcHalo h; h.r0 = h.r1 = h.r2 = (u32x4){0u, 0u, 0u, 0u};
    if (gt < 8 * nseg * 256) {
        const int strip = gt & 255, sg = (gt >> 8) % nseg, b = (gt >> 8) / nseg, s0 = sg * seglen;
        if (s0 > 0) {
            const bf16_t* p = zx + ((size_t)b * SEQ + s0 - 3) * 6144 + 4096 + strip * 8;
            h.r0 = *(const u32x4*)p; h.r1 = *(const u32x4*)(p + 6144); h.r2 = *(const u32x4*)(p + 2 * 6144);
        }
    }
    return h;
}
__device__ __forceinline__ void bc_preact_walk(bf16_t* zx, const float* __restrict__ conv_w, const float* __restrict__ conv_b, const BcHalo& h, int bid, int nb, int wv) {
    const int gt = bid * NTHREADS + opaque_tid(wv), nseg = bc_nseg(nb), seglen = SEQ / nseg;
    if (gt >= 8 * nseg * 256) return;
    const int strip = gt & 255, sg = (gt >> 8) % nseg, b = (gt >> 8) / nseg, s0 = sg * seglen;
    float wt[8][5];
#pragma unroll
    for (int c = 0; c < 8; c++) {
#pragma unroll
        for (int k = 0; k < 4; k++) wt[c][k] = conv_w[k * 4096 + 2048 + strip * 8 + c];
        wt[c][4] = conv_b[2048 + strip * 8 + c];
    }
    bf16_t* p = zx + ((size_t)b * SEQ + s0) * 6144 + 4096 + strip * 8;
    float f0[8], f1[8], f2[8];
#pragma unroll
    for (int c = 0; c < 8; c++) { f0[c] = elem8(h.r0, c); f1[c] = elem8(h.r1, c); f2[c] = elem8(h.r2, c); }
    u32x4 cur[4];
#pragma unroll
    for (int j = 0; j < 4; j++) cur[j] = *(const u32x4*)(p + (size_t)j * 6144);
#pragma unroll 1
    for (int r = 0; r < seglen; r += 4) {
        u32x4 nxt[4];
        const int rn = r + 4 < seglen ? r + 4 : r;
#pragma unroll
        for (int j = 0; j < 4; j++) nxt[j] = *(const u32x4*)(p + (size_t)(rn + j) * 6144);
#pragma unroll
        for (int j = 0; j < 4; j++) {
            const u32x4 row = cur[j];
            unsigned pk[4]; float oprev = 0.f;
#pragma unroll
            for (int c = 0; c < 8; c++) {
                const float f3 = elem8(row, c);
                const float o = silu_f(wt[c][4] + wt[c][0] * f0[c] + wt[c][1] * f1[c] + wt[c][2] * f2[c] + wt[c][3] * f3);
                if (c & 1) pk[c >> 1] = pack2(oprev, o); else oprev = o;
                f0[c] = f1[c]; f1[c] = f2[c]; f2[c] = f3;
            }
            *(u32x4*)(p + (size_t)(r + j) * 6144) = (u32x4){pk[0], pk[1], pk[2], pk[3]};
            asm volatile("" ::: "memory");
        }
#pragma unroll
        for (int j = 0; j < 4; j++) cur[j] = nxt[j];
    }
}
__device__ __forceinline__ void ssd_chunked(const bf16_t* __restrict__ zx, const float* __restrict__ dtraw, const float* __restrict__ conv_w, const float* __restrict__ conv_b,
                        const float* __restrict__ dt_bias, const float* __restrict__ A_log, const float* __restrict__ Dskip,
                        bf16_t* __restrict__ ybuf, float* __restrict__ ssq, int bid, int nb, unsigned char* smem, int wv) {
    bf16_t* Cs = (bf16_t*)(smem + SSD_OFF_C); bf16_t* Bs = (bf16_t*)(smem + SSD_OFF_B); bf16_t* BTs = (bf16_t*)(smem + SSD_OFF_BT);
    bf16_t* XdT = (bf16_t*)(smem + SSD_OFF_XD); bf16_t* XddT = (bf16_t*)(smem + SSD_OFF_XDD); bf16_t* Ms = (bf16_t*)(smem + SSD_OFF_M);
    float* fbuf = (float*)(smem + SSD_OFF_F); float* part = fbuf + 2 * 320;
    float* cwl = (float*)(smem + SSD_OFF_CW);
    const int tid = opaque_tid(wv), lane = tid & 63, w = tid >> 6, l15 = lane & 15, quad = lane >> 4, pq = w & 3, lh = w >> 2;
    for (int item = bid; item < 256; item += nb) {
        const int b = item >> 5, head = item & 31, g = head >> 2;
        const float Aneg = -__expf(A_log[head]), dtb = dt_bias[head], Dh = Dskip[head];
        const bool xt = tid < 256;
        const int cgl = xt ? (tid & 7) : ((tid - 256) & 15);
        const int isC = xt ? 0 : ((tid - 256) >> 4) & 1;
        const int tgp = xt ? (tid >> 3) : ((tid - 256) >> 5);
        const int rbase = xt ? tgp * 2 - 3 : tgp * 8;
        const int col = xt ? 2048 + head * 64 + cgl * 8 : 4096 + isC * 1024 + g * 128 + cgl * 8;
        for (int i = tid; i < 5 * 64; i += NTHREADS) {
            const int k = i / 64, lc = i % 64;
            cwl[(lc >> 3) * 41 + (lc & 7) * 5 + k] = k < 4 ? conv_w[k * 4096 + head * 64 + lc] : conv_b[head * 64 + lc];
        }
        const float* cwp = cwl + (xt ? cgl : 0) * 41;
        f32x4 Hacc[8];
#pragma unroll
        for (int nt = 0; nt < 8; nt++) Hacc[nt] = (f32x4){0.f, 0.f, 0.f, 0.f};
        float dtv_next = 0.f;
        if (w == 7) dtv_next = dtraw[((size_t)b * SEQ + lane) * 32 + head];
        u32x4 rawn[8];
#pragma unroll
        for (int j = 0; j < 8; j++) {
            rawn[j] = (u32x4){0u, 0u, 0u, 0u};
            if (!xt || j < 5) {
                const int srow = rbase + j;
                const u32x4 rv = *(const u32x4*)(zx + ((size_t)b * SEQ + (srow < 0 ? 0 : srow)) * 6144 + col);
                rawn[j] = srow >= 0 ? rv : (u32x4){0u, 0u, 0u, 0u};
            }
        }
        for (int ck = 0; ck < 64; ck++) {
            const int s0 = ck * 64;
            const size_t t0 = (size_t)b * SEQ + s0;
            float* fdt = fbuf + (ck & 1) * 320; float* fcs = fdt + 64; float* fecs = fcs + 64; float* fwl = fecs + 64; float* fidt = fwl + 64;
            if (ck == 0 && w == 7) { SSD_FILL_F(fbuf, 0); dtv_next = dtraw[(t0 + 64 + lane) * 32 + head]; }
            __syncthreads();
            if (ck > 0 && tid < 64) ssq[(t0 - 64 + tid) * 32 + head] = part[tid] + part[64 + tid] + part[128 + tid] + part[192 + tid];
            if (w == 7 && ck + 1 < 64) { SSD_FILL_F(fbuf + ((ck + 1) & 1) * 320, ck + 1); if (ck + 2 < 64) dtv_next = dtraw[(t0 + 128 + lane) * 32 + head]; }
            if (xt) {
                const f32x2 dl = *(const f32x2*)(fdt + 2 * tgp), wl2 = *(const f32x2*)(fwl + 2 * tgp);
#pragma unroll
                for (int c = 0; c < 8; c++) {
                    const float w0 = cwp[c * 5], w1 = cwp[c * 5 + 1], w2 = cwp[c * 5 + 2], w3 = cwp[c * 5 + 3], bb = cwp[c * 5 + 4];
                    float e[5];
#pragma unroll
                    for (int j = 0; j < 5; j++) e[j] = elem8(rawn[j], c);
                    const float o0 = silu_f(bb + w0 * e[0] + w1 * e[1] + w2 * e[2] + w3 * e[3]) * dl[0];
                    const float o1 = silu_f(bb + w0 * e[1] + w1 * e[2] + w2 * e[3] + w3 * e[4]) * dl[1];
                    const int pos = (cgl * 8 + c) * S_LT + (((tgp >> 2) ^ (cgl & 7)) * 8 + (tgp & 3) * 2);
                    *(unsigned*)(XdT + pos) = pack2(o0, o1);
                    *(unsigned*)(XddT + pos) = pack2(o0 * wl2[0], o1 * wl2[1]);
                }
            } else {
                bf16_t* rowmaj = isC ? Cs : Bs;
#pragma unroll
                for (int j = 0; j < 8; j++) *(u32x4*)(rowmaj + (tgp * 8 + j) * S_LC + cgl * 8) = rawn[j];
                if (!isC) {
#pragma unroll
                    for (int hf = 0; hf < 2; hf++)
#pragma unroll
                        for (int c = 0; c < 8; c++) {
#define SSD_W(v_) ((c) < 2 ? (v_).x : (c) < 4 ? (v_).y : (c) < 6 ? (v_).z : (v_).w)
                            const unsigned sel = (c & 1) ? 0x07060302u : 0x05040100u;
                            const unsigned p01 = __builtin_amdgcn_perm(SSD_W(rawn[hf * 4 + 1]), SSD_W(rawn[hf * 4 + 0]), sel);
                            const unsigned p23 = __builtin_amdgcn_perm(SSD_W(rawn[hf * 4 + 3]), SSD_W(rawn[hf * 4 + 2]), sel);
                            *(u32x2*)(BTs + (cgl * 8 + c) * S_LT + ((tgp ^ (cgl & 7)) * 8 + hf * 4)) = (u32x2){p01, p23};
                        }
                }
            }
            if (ck + 1 < 64) {
#pragma unroll
                for (int j = 0; j < 8; j++) if (!xt || j < 5) rawn[j] = *(const u32x4*)(zx + (t0 + 64 + rbase + j) * 6144 + col);
            }
            bf16_t zreg[2][4];
#pragma unroll
            for (int h2 = 0; h2 < 2; h2++)
#pragma unroll
                for (int r = 0; r < 4; r++) zreg[h2][r] = zx[(t0 + (2 * lh + h2) * 16 + quad * 4 + r) * 6144 + head * 64 + pq * 16 + l15];
            __syncthreads();
            {
                const int lt = w & 3;
#pragma unroll
                for (int h2 = 0; h2 < 2; h2++) {
                    const int st = 2 * (w >> 2) + h2;
                    f32x4 gacc = (f32x4){0.f, 0.f, 0.f, 0.f};
                    if (st <= lt) {
#pragma unroll
                        for (int ks = 0; ks < 4; ks++) {
                            const bf16x8 a = *(const bf16x8*)(Bs + (st * 16 + l15) * S_LC + ks * 32 + quad * 8);
                            const bf16x8 bb = *(const bf16x8*)(Cs + (lt * 16 + l15) * S_LC + ks * 32 + quad * 8);
                            gacc = __builtin_amdgcn_mfma_f32_16x16x32_bf16(a, bb, gacc, 0, 0, 0);
                        }
                        const int l = lt * 16 + l15; const float csl = fcs[l];
#pragma unroll
                        for (int r = 0; r < 4; r++) { const int sidx = st * 16 + quad * 4 + r; gacc[r] = sidx <= l ? gacc[r] * __expf(csl - fcs[sidx]) : 0.f; }
                    }
                    *(u32x2*)(Ms + (lt * 16 + l15) * S_LT + st * 16 + quad * 4) = (u32x2){pack2(gacc[0], gacc[1]), pack2(gacc[2], gacc[3])};
                }
            }
            __syncthreads();
            bf16x8 hb[4];
#pragma unroll
            for (int s4 = 0; s4 < 4; s4++) {
                const u32x4 pk = (u32x4){pack2(Hacc[2 * s4][0], Hacc[2 * s4][1]), pack2(Hacc[2 * s4][2], Hacc[2 * s4][3]),
                                         pack2(Hacc[2 * s4 + 1][0], Hacc[2 * s4 + 1][1]), pack2(Hacc[2 * s4 + 1][2], Hacc[2 * s4 + 1][3])};
                hb[s4] = __builtin_bit_cast(bf16x8, pk);
            }
#pragma unroll
            for (int h2 = 0; h2 < 2; h2++) {
                const int lt = 2 * lh + h2;
                f32x4 yd = (f32x4){0.f, 0.f, 0.f, 0.f}, yo = (f32x4){0.f, 0.f, 0.f, 0.f};
#pragma unroll
                for (int ks = 0; ks < 2; ks++) {
                    if (ks == 0 || lt >= 2) {
                        const bf16x8 a = *(const bf16x8*)(Ms + (lt * 16 + l15) * S_LT + ks * 32 + quad * 8);
                        const bf16x8 bb = *(const bf16x8*)(XdT + (pq * 16 + l15) * S_LT + (((ks * 4 + quad) ^ ((pq * 2 + (l15 >> 3)) & 7)) * 8));
                        yd = __builtin_amdgcn_mfma_f32_16x16x32_bf16(a, bb, yd, 0, 0, 0);
                    }
                }
#pragma unroll
                for (int s4 = 0; s4 < 4; s4++) {
                    const u32x2 c0 = *(const u32x2*)(Cs + (lt * 16 + l15) * S_LC + s4 * 32 + quad * 4);
                    const u32x2 c1 = *(const u32x2*)(Cs + (lt * 16 + l15) * S_LC + s4 * 32 + 16 + quad * 4);
                    const bf16x8 a = __builtin_bit_cast(bf16x8, ((u32x4){c0.x, c0.y, c1.x, c1.y}));
                    yo = __builtin_amdgcn_mfma_f32_16x16x32_bf16(a, hb[s4], yo, 0, 0, 0);
                }
                const int p = pq * 16 + l15, lb = lt * 16 + quad * 4;
                const u32x2 xw = *(const u32x2*)(XdT + p * S_LT + ((((lb >> 3) ^ ((p >> 3) & 7)) * 8) + (lb & 7)));
                const float xdv[4] = {bflo(xw.x), bfhi(xw.x), bflo(xw.y), bfhi(xw.y)};
                float sq[4];
#pragma unroll
                for (int r = 0; r < 4; r++) {
                    const int l = lb + r;
                    const float yv = yd[r] + fecs[l] * yo[r] + Dh * xdv[r] * fidt[l];
                    const float zv = bf2f(zreg[h2][r]);
                    const float yg = yv * silu_f(zv);
                    ybuf[(t0 + l) * 2048 + head * 64 + p] = f2bf(yg);
                    float q2 = yg * yg;
                    q2 += dpp_row_ror<8>(q2); q2 += dpp_row_ror<4>(q2); q2 += dpp_row_ror<2>(q2); q2 += dpp_row_ror<1>(q2);
                    sq[r] = q2;
                }
                if (l15 == 0) *(f32x4*)(part + pq * 64 + lb) = (f32x4){sq[0], sq[1], sq[2], sq[3]};
            }
            {
                const float dec = fecs[63];
#pragma unroll
                for (int nt = 0; nt < 8; nt++) {
                    f32x4 hh = Hacc[nt] * dec;
#pragma unroll
                    for (int ks = 0; ks < 2; ks++) {
                        const bf16x8 a = *(const bf16x8*)(BTs + (nt * 16 + l15) * S_LT + (((ks * 4 + quad) ^ ((nt * 2 + (l15 >> 3)) & 7)) * 8));
                        const bf16x8 bb = *(const bf16x8*)(XddT + (pq * 16 + l15) * S_LT + (((ks * 4 + quad) ^ ((pq * 2 + (l15 >> 3)) & 7)) * 8));
                        hh = __builtin_amdgcn_mfma_f32_16x16x32_bf16(a, bb, hh, 0, 0, 0);
                    }
                    Hacc[nt] = hh;
                }
            }
        }
        __syncthreads();
        if (tid < 64) ssq[((size_t)b * SEQ + 63 * 64 + tid) * 32 + head] = part[tid] + part[64 + tid] + part[128 + tid] + part[192 + tid];
        __syncthreads();
    }
}

__device__ __forceinline__ void ynorm_phase(bf16_t* ybuf, const float* __restrict__ ssq, const float* __restrict__ gate_norm, int bid, int nb, int wv) {
    const size_t nvec = (size_t)T * 2048 / 8; const int tid = opaque_tid(wv);
    for (size_t i = (size_t)bid * NTHREADS + tid; i < nvec; i += (size_t)nb * NTHREADS) {
        const size_t t = i >> 8; const int c = (int)(i & 255) * 8, g = c >> 8;
        const f32x4 s4 = *(const f32x4*)(ssq + t * 32 + g * 4);
        const float r = rsqrtf((s4[0] + s4[1] + s4[2] + s4[3]) * (1.f / 256.f) + 1e-5f);
        u32x4 v = *(u32x4*)(ybuf + t * 2048 + c);
        const float4 g0 = *(const float4*)(gate_norm + c), g1 = *(const float4*)(gate_norm + c + 4);
        v.x = pack2(bflo(v.x) * r * g0.x, bfhi(v.x) * r * g0.y); v.y = pack2(bflo(v.y) * r * g0.z, bfhi(v.y) * r * g0.w);
        v.z = pack2(bflo(v.z) * r * g1.x, bfhi(v.z) * r * g1.y); v.w = pack2(bflo(v.w) * r * g1.z, bfhi(v.w) * r * g1.w);
        *(u32x4*)(ybuf + t * 2048 + c) = v;
    }
}

__device__ __forceinline__ void rope_phase(bf16_t* qatt, bf16_t* kvbuf, const int* __restrict__ pos, int bid, int nb, int wv) {
    const int tid = opaque_tid(wv);
    pg8::StaticOrder SO; SO.init(T, 1280, nb, bid);
    pg8::Unit un;
    for (int ui = 0; SO.next(ui, un); ui++) {
        const int nh = un.pn == 0 ? 2 : 4, hb = un.pn == 0 ? 16 : 4 * (un.pn - 1);
        for (int i = tid; i < 256 * nh * 8; i += NTHREADS) {
            const int pr = i & 7, hd = hb + ((i >> 3) & (nh - 1)), t = un.pm * 256 + i / (8 * nh);
            const float inv = exp2f(-(float)pr * (18.931568569324174f / 8.f));
            const double rev = (double)pos[t] * (double)inv * 0.15915494309189535;
            const float fr = (float)(rev - floor(rev));
            const float sn = __builtin_amdgcn_sinf(fr), cs = __builtin_amdgcn_cosf(fr);
            bf16_t* ptr = hd < 16 ? qatt + (size_t)t * 1024 + hd * 64 : kvbuf + (size_t)t * 256 + (hd - 16) * 64;
            const float t1 = bf2f(ptr[pr]), t2 = bf2f(ptr[pr + 8]);
            ptr[pr] = f2bf(t1 * cs - t2 * sn); ptr[pr + 8] = f2bf(t2 * cs + t1 * sn);
        }
    }
}

constexpr int AT_KS = 72, AT_VS = 264;
__device__ __forceinline__ void attn_mfma(const bf16_t* __restrict__ qatt, const bf16_t* __restrict__ kvbuf, const float* __restrict__ sinks, bf16_t* __restrict__ aout, int bid, int nb, bf16_t* sm, int wv) {
    bf16_t* Ks = sm; bf16_t* Vt = sm + 256 * AT_KS;
    const int tid = opaque_tid(wv), lane = tid & 63, w = tid >> 6, l31 = lane & 31, half = lane >> 5;
    for (int item = bid; item < 512; item += nb) {
        const int g = item & 1, n = (item >> 1) & 31, b = item >> 6;
        const size_t tq0 = (size_t)b * SEQ + n * 128;
#pragma unroll
        for (int i = 0; i < 4; i++) {
            const int c = tid + 512 * i, kj = c >> 3, ch = c & 7;
            const bool ok = (n > 0) || (kj >= 128);
            const size_t tok = ok ? (tq0 - 128 + kj) : tq0;
            u32x4 kv = *(const u32x4*)(kvbuf + tok * 256 + g * 64 + ch * 8);
            u32x4 vv = *(const u32x4*)(kvbuf + tok * 256 + 128 + g * 64 + ch * 8);
            if (!ok) { kv = (u32x4){0u, 0u, 0u, 0u}; vv = kv; }
            *(u32x4*)(Ks + kj * AT_KS + ch * 8) = kv;
            const unsigned vw[4] = {vv.x, vv.y, vv.z, vv.w};
#pragma unroll
            for (int e = 0; e < 4; e++) { Vt[(ch * 8 + 2 * e) * AT_VS + kj] = (bf16_t)(vw[e] & 0xffffu); Vt[(ch * 8 + 2 * e + 1) * AT_VS + kj] = (bf16_t)(vw[e] >> 16); }
        }
        __syncthreads();
        const int hq = g * 8 + w;
        const float sink = sinks[hq];
#pragma unroll 1
        for (int qt = 0; qt < 4; qt++) {
            const bf16_t* qrow = qatt + (tq0 + qt * 32 + l31) * 1024 + hq * 64 + half * 8;
            bf16x8 qf[4];
#pragma unroll
            for (int ks = 0; ks < 4; ks++) qf[ks] = *(const bf16x8*)(qrow + ks * 16);
            f32x16 sacc[5];
#pragma unroll
            for (int kt = 0; kt < 5; kt++) {
#pragma unroll
                for (int r = 0; r < 16; r++) sacc[kt][r] = 0.f;
#pragma unroll
                for (int ks = 0; ks < 4; ks++) {
                    const bf16x8 a = *(const bf16x8*)(Ks + ((qt + kt) * 32 + l31) * AT_KS + ks * 16 + half * 8);
                    sacc[kt] = __builtin_amdgcn_mfma_f32_32x32x16_bf16(a, qf[ks], sacc[kt], 0, 0, 0);
                }
            }
            const int qi = qt * 32 + l31;
            float m = sink;
#pragma unroll
            for (int kt = 0; kt < 5; kt++)
#pragma unroll
                for (int r = 0; r < 16; r++) {
                    const int kj = (qt + kt) * 32 + (r & 3) + 8 * (r >> 2) + 4 * half;
                    const bool valid = kj > qi && kj <= qi + 128 && (n > 0 || kj >= 128);
                    sacc[kt][r] = valid ? sacc[kt][r] : -INFINITY;
                    m = fmaxf(m, sacc[kt][r]);
                }
            m = fmaxf(m, bperm(m, lane ^ 32));
            float sum = 0.f;
#pragma unroll
            for (int kt = 0; kt < 5; kt++)
#pragma unroll
                for (int r = 0; r < 16; r++) { const float p = __expf(sacc[kt][r] - m); sacc[kt][r] = p; sum += p; }
            sum += bperm(sum, lane ^ 32);
            sum += __expf(sink - m);
            f32x16 oacc[2];
#pragma unroll
            for (int dt = 0; dt < 2; dt++)
#pragma unroll
                for (int r = 0; r < 16; r++) oacc[dt][r] = 0.f;
#pragma unroll
            for (int kt = 0; kt < 5; kt++)
#pragma unroll
                for (int s2 = 0; s2 < 2; s2++) {
                    const u32x4 pk = (u32x4){pack2(sacc[kt][8 * s2 + 0], sacc[kt][8 * s2 + 1]), pack2(sacc[kt][8 * s2 + 2], sacc[kt][8 * s2 + 3]),
                                             pack2(sacc[kt][8 * s2 + 4], sacc[kt][8 * s2 + 5]), pack2(sacc[kt][8 * s2 + 6], sacc[kt][8 * s2 + 7])};
                    const bf16x8 pf = __builtin_bit_cast(bf16x8, pk);
#pragma unroll
                    for (int dt = 0; dt < 2; dt++) {
                        const bf16_t* vp = Vt + (dt * 32 + l31) * AT_VS + (qt + kt) * 32 + 16 * s2 + 4 * half;
                        const u32x2 v0 = *(const u32x2*)vp, v1 = *(const u32x2*)(vp + 8);
                        const bf16x8 a = __builtin_bit_cast(bf16x8, ((u32x4){v0.x, v0.y, v1.x, v1.y}));
                        oacc[dt] = __builtin_amdgcn_mfma_f32_32x32x16_bf16(a, pf, oacc[dt], 0, 0, 0);
                    }
                }
            const float inv = 1.f / sum;
            bf16_t* orow = aout + (tq0 + qt * 32 + l31) * 1024 + hq * 64 + 4 * half;
#pragma unroll
            for (int dt = 0; dt < 2; dt++)
#pragma unroll
                for (int r4 = 0; r4 < 4; r4++)
                    *(u32x2*)(orow + dt * 32 + 8 * r4) = (u32x2){pack2(oacc[dt][4 * r4] * inv, oacc[dt][4 * r4 + 1] * inv), pack2(oacc[dt][4 * r4 + 2] * inv, oacc[dt][4 * r4 + 3] * inv)};
        }
        __syncthreads();
    }
}

constexpr int RK_LDS = 136;
struct PairTab { unsigned char i[50], j[50]; };
constexpr PairTab make_pairs() { PairTab t{}; int p = 0; for (int i = 0; i < 16; i++) for (int j = 0; j < 16 / (i + 1); j++) { t.i[p] = (unsigned char)i; t.j[p] = (unsigned char)j; p++; } return t; }
constexpr PairTab PAIRS = make_pairs();
#define CE_DESC(a, b) do { const float hi_ = fmaxf(a, b), lo_ = fminf(a, b); a = hi_; b = lo_; } while (0)
#define CE_ASC(a, b)  do { const float hi_ = fmaxf(a, b), lo_ = fminf(a, b); a = lo_; b = hi_; } while (0)
template <int OFF> __device__ __forceinline__ void sort16_desc(float (&v)[64]) {
#pragma unroll
    for (int k = 2; k <= 16; k <<= 1)
#pragma unroll
        for (int j = k >> 1; j > 0; j >>= 1)
#pragma unroll
            for (int i = 0; i < 16; i++) {
                const int l = i ^ j;
                if (l > i) { if ((i & k) == 0) CE_DESC(v[OFF + i], v[OFF + l]); else CE_ASC(v[OFF + i], v[OFF + l]); }
            }
}
__device__ __forceinline__ void clean16_desc(float (&c)[16]) {
#pragma unroll
    for (int j = 8; j > 0; j >>= 1)
#pragma unroll
        for (int i = 0; i < 16; i++) { const int l = i ^ j; if (l > i) CE_DESC(c[i], c[l]); }
}
template <int A, int B> __device__ __forceinline__ void merge_top16(float (&v)[64]) {
    float c[16];
#pragma unroll
    for (int i = 0; i < 16; i++) c[i] = fmaxf(v[A + i], v[B + 15 - i]);
    clean16_desc(c);
#pragma unroll
    for (int i = 0; i < 16; i++) v[A + i] = c[i];
}
__device__ __forceinline__ void top16_of_64(float (&v)[64]) {
    sort16_desc<0>(v); sort16_desc<16>(v); sort16_desc<32>(v); sort16_desc<48>(v);
    merge_top16<0, 16>(v); merge_top16<32, 48>(v); merge_top16<0, 32>(v);
}
__device__ __forceinline__ void peer_route_mfma(const bf16_t* __restrict__ qbuf, const float* __restrict__ sk, int* __restrict__ idxb, float* __restrict__ gateb, int bid, int nb, bf16_t* sm, int wv) {
    const int tid = opaque_tid(wv), lane = tid & 63, w = tid >> 6, l31 = lane & 31, half = lane >> 5;
    for (int i = tid; i < 256 * 32; i += NTHREADS) {
        const int row = i >> 5, c4 = (i & 31) * 4;
        const float4 v = *(const float4*)(sk + (size_t)row * 128 + c4);
        *(u32x2*)(sm + row * RK_LDS + c4) = (u32x2){pack2(v.x, v.y), pack2(v.z, v.w)};
    }
    __syncthreads();
    pg8::StaticOrder SO; SO.init(T, 2048, nb, bid);
    pg8::Unit un;
    for (int ui = 0; SO.next(ui, un); ui++) {
        const int tg = un.pm * 8 + w, head = un.pn;
        const bf16_t* qrow = qbuf + (size_t)(tg * 32 + l31) * 2048 + head * 256 + half * 8;
        float tops[2][16];
#pragma unroll 1
        for (int c = 0; c < 2; c++) {
            f32x16 acc[4];
#pragma unroll
            for (int kt = 0; kt < 4; kt++)
#pragma unroll
                for (int r = 0; r < 16; r++) acc[kt][r] = 0.f;
            bf16x8 bq[8];
#pragma unroll
            for (int ks = 0; ks < 8; ks++) bq[ks] = *(const bf16x8*)(qrow + c * 128 + ks * 16);
#pragma unroll
            for (int ks = 0; ks < 8; ks++)
#pragma unroll
                for (int kt = 0; kt < 4; kt++) {
                    const bf16x8 a = *(const bf16x8*)(sm + (c * 128 + kt * 32 + l31) * RK_LDS + ks * 16 + half * 8);
                    acc[kt] = __builtin_amdgcn_mfma_f32_32x32x16_bf16(a, bq[ks], acc[kt], 0, 0, 0);
                }
            float v[64];
#pragma unroll
            for (int kt = 0; kt < 4; kt++)
#pragma unroll
                for (int r = 0; r < 16; r++) {
                    const unsigned key = (unsigned)(kt * 32 + (r & 3) + 8 * (r >> 2)) | ((unsigned)half << 2);
                    v[kt * 16 + r] = __uint_as_float((__float_as_uint(acc[kt][r]) & ~127u) | key);
                }
            float cur[16];
            top16_of_64(v);
            {
                float cm[16];
#pragma unroll
                for (int i = 0; i < 16; i++) cm[i] = fmaxf(v[i], bperm(v[15 - i], lane ^ 32));
                clean16_desc(cm);
#pragma unroll
                for (int i = 0; i < 16; i++) cur[i] = cm[i];
            }
            if (c == 0) {
#pragma unroll
                for (int rd = 0; rd < 16; rd++) tops[0][rd] = cur[rd];
            } else {
#pragma unroll
                for (int rd = 0; rd < 16; rd++) tops[1][rd] = cur[rd];
            }
        }
        float cand[64];
#pragma unroll
        for (int p = 0; p < 50; p++) {
            const float sum = tops[0][PAIRS.i[p]] + tops[1][PAIRS.j[p]];
            cand[p] = __uint_as_float((__float_as_uint(sum) & ~255u) | (unsigned)(PAIRS.i[p] * 16 + PAIRS.j[p]));
        }
#pragma unroll
        for (int p = 50; p < 64; p++) cand[p] = -INFINITY;
        top16_of_64(cand);
        float sel[16];
#pragma unroll
        for (int rd = 0; rd < 16; rd++) sel[rd] = cand[rd];
        unsigned k1[4], k2[4];
#pragma unroll
        for (int q4 = 0; q4 < 4; q4++) {
            k1[q4] = 0u; k2[q4] = 0u;
#pragma unroll
            for (int b = 0; b < 4; b++) {
                k1[q4] |= (__float_as_uint(tops[0][q4 * 4 + b]) & 127u) << (8 * b);
                k2[q4] |= (__float_as_uint(tops[1][q4 * 4 + b]) & 127u) << (8 * b);
            }
        }
        float ex[16]; float ssum = 0.f;
#pragma unroll
        for (int k = 0; k < 16; k++) { ex[k] = __expf(sel[k] - sel[0]); ssum += ex[k]; }
        const float inv = 1.f / ssum;
        unsigned outw[16];
#pragma unroll
        for (int k = 0; k < 16; k++) {
            const unsigned bits = __float_as_uint(sel[k]) & 255u, ii = bits >> 4, jj = bits & 15u;
            const unsigned d1 = (ii >> 2) == 0 ? k1[0] : (ii >> 2) == 1 ? k1[1] : (ii >> 2) == 2 ? k1[2] : k1[3];
            const unsigned d2 = (jj >> 2) == 0 ? k2[0] : (jj >> 2) == 1 ? k2[1] : (jj >> 2) == 2 ? k2[2] : k2[3];
            const unsigned e1 = (d1 >> (8 * (ii & 3))) & 127u, e2 = (d2 >> (8 * (jj & 3))) & 127u;
            const unsigned idx = e1 * 128u + e2;
            outw[k] = half == 0 ? idx : __float_as_uint(ex[k] * inv);
        }
        unsigned* dst = (half == 0 ? (unsigned*)idxb : (unsigned*)gateb) + ((size_t)(tg * 32 + l31) * 8 + head) * 16;
#pragma unroll
        for (int q4 = 0; q4 < 4; q4++) *(u32x4*)(dst + q4 * 4) = (u32x4){outw[q4 * 4], outw[q4 * 4 + 1], outw[q4 * 4 + 2], outw[q4 * 4 + 3]};
    }
    __syncthreads();
}

typedef unsigned u32x6 __attribute__((ext_vector_type(6)));
typedef float f32x32 __attribute__((ext_vector_type(32)));
struct Row6 { u32x4 a; u32x2 b; };
__device__ __forceinline__ Row6 ld6(const unsigned char* __restrict__ tab, int ie, int hl) {
    Row6 r; const unsigned char* p = tab + (size_t)ie * ROWB;
    r.a = *(const u32x4*)(p + hl * 16); r.b = *(const u32x2*)(p + 512 + hl * 8); return r;
}
__device__ __forceinline__ f32x32 dec6(const Row6& r) {
    const u32x6 sv = {r.a.x, r.a.y, r.a.z, r.a.w, r.b.x, r.b.y};
    return __builtin_amdgcn_cvt_scalef32_pk32_f32_fp6(sv, 1.0f);
}
typedef __bf16 hw_bf16x32 __attribute__((ext_vector_type(32)));
__device__ __forceinline__ float dot32_fp6(const Row6& r, const unsigned (&hp)[16]) {
    const u32x6 sv = {r.a.x, r.a.y, r.a.z, r.a.w, r.b.x, r.b.y};
    const hw_bf16x32 d = __builtin_amdgcn_cvt_scalef32_pk32_bf16_fp6(sv, 1.0f);
    float p0 = 0.f, p1 = 0.f;
#pragma unroll
    for (int k = 0; k < 8; k++) {
        const hw_bf16x2 a0 = {d[4 * k], d[4 * k + 1]}, a1 = {d[4 * k + 2], d[4 * k + 3]};
        p0 = __builtin_amdgcn_fdot2_f32_bf16(a0, __builtin_bit_cast(hw_bf16x2, hp[2 * k]), p0, false);
        p1 = __builtin_amdgcn_fdot2_f32_bf16(a1, __builtin_bit_cast(hw_bf16x2, hp[2 * k + 1]), p1, false);
    }
    return p0 + p1;
}
__device__ __forceinline__ int sel_half_i(int v, int s, int hh) { const int a = __builtin_amdgcn_readlane(v, 2 * s), b = __builtin_amdgcn_readlane(v, 2 * s + 1); return hh ? b : a; }
__device__ __forceinline__ float sel_half_f(float v, int s, int hh) { const float a = rl_f(v, 2 * s), b = rl_f(v, 2 * s + 1); return hh ? b : a; }
__device__ __forceinline__ void peer_u(const bf16_t* __restrict__ xb_in, const float* __restrict__ ssq_in, const unsigned char* __restrict__ u6,
                            const float* __restrict__ su, const float* __restrict__ sv, const int* __restrict__ idxb, float* __restrict__ gateb, int bid, int nb, float* sm, int wv) {
    const int tid = opaque_tid(wv), w = tid >> 6, lane = tid & 63, hl = lane & 31, hh = lane >> 5;
    float* scr = sm + w * (32 * 66);
    const int tstride = nb * NW, t0 = bid * NW + w;
    const int nh = 2 * ((T + tstride - 1) / tstride);
#define UTOK(g_) min(t0 + ((g_) >> 1) * tstride, T - 1)
#define UMETA_OFF(g_) ((size_t)UTOK(g_) * 128 + ((g_) & 1) * 64 + lane)
    int idx_c = idxb[UMETA_OFF(0)], idx_n = idxb[UMETA_OFF(1)], idx_nn = idx_n;
    unsigned hp[16], hq[16];
#pragma unroll
    for (int q4 = 0; q4 < 4; q4++) {
        const u32x4 a = *(const u32x4*)(xb_in + (size_t)UTOK(0) * DM + hl * 32 + q4 * 8);
        hp[q4 * 4 + 0] = a.x; hp[q4 * 4 + 1] = a.y; hp[q4 * 4 + 2] = a.z; hp[q4 * 4 + 3] = a.w;
        hq[q4 * 4 + 0] = a.x; hq[q4 * 4 + 1] = a.y; hq[q4 * 4 + 2] = a.z; hq[q4 * 4 + 3] = a.w;
    }
    Row6 qa[4], qb[4];
#pragma unroll
    for (int j = 0; j < 4; j++) qa[j] = ld6(u6, sel_half_i(idx_c, j, hh), hl);
#pragma unroll
    for (int j = 0; j < 4; j++) qb[j] = ld6(u6, sel_half_i(idx_c, 4 + j, hh), hl);
#pragma unroll
    for (int j = 0; j < 4; j++) asm volatile("" : "+v"(qa[j].a), "+v"(qa[j].b), "+v"(qb[j].a), "+v"(qb[j].b));
#pragma unroll
    for (int j = 0; j < 16; j += 4) asm volatile("" : "+v"(hp[j]), "+v"(hp[j + 1]), "+v"(hp[j + 2]), "+v"(hp[j + 3]));
    asm volatile("" : "+v"(idx_c), "+v"(idx_n));
#pragma unroll 1
    for (int g = 0; g < nh; g++) {
        const int t = UTOK(g);
        const bool active = t0 + (g >> 1) * tstride < T;
        idx_nn = idxb[UMETA_OFF(min(g + 2, nh - 1))];
        const float my_gate = gateb[(size_t)t * 128 + (g & 1) * 64 + lane];
        const float my_su = su[idx_c], my_sv = sv[idx_c];
        {
            const int tn = UTOK(min(g + 1, nh - 1));
#pragma unroll
            for (int q4 = 0; q4 < 4; q4++) {
                const u32x4 a = *(const u32x4*)(xb_in + (size_t)tn * DM + hl * 32 + q4 * 8);
                hq[q4 * 4 + 0] = a.x; hq[q4 * 4 + 1] = a.y; hq[q4 * 4 + 2] = a.z; hq[q4 * 4 + 3] = a.w;
            }
        }
        const float my_ssq = ssq_in[(size_t)t * 16 + (lane & 15)];
#pragma unroll
        for (int bb = 0; bb < 4; bb++) {
#pragma unroll
            for (int j = 0; j < 4; j++) scr[(8 * bb + j) * 66 + hh * 33 + hl] = dot32_fp6(qa[j], hp);
#pragma unroll
            for (int j = 0; j < 4; j++) qa[j] = ld6(u6, sel_half_i(bb < 3 ? idx_c : idx_n, (8 * bb + 8 + j) & 31, hh), hl);
            __builtin_amdgcn_sched_barrier(0);
#pragma unroll
            for (int j = 0; j < 4; j++) scr[(8 * bb + 4 + j) * 66 + hh * 33 + hl] = dot32_fp6(qb[j], hp);
#pragma unroll
            for (int j = 0; j < 4; j++) qb[j] = ld6(u6, sel_half_i(bb < 3 ? idx_c : idx_n, (8 * bb + 12 + j) & 31, hh), hl);
            __builtin_amdgcn_sched_barrier(0);
        }
        __syncthreads();
        float a = 0.f;
#pragma unroll 16
        for (int l = 0; l < 32; l++) a += scr[lane * 33 + l];
        __syncthreads();
        const float rs = rsqrtf(wave_sum(my_ssq) * (0.25f / DM) + 1e-6f);
        a *= my_su * rs;
        const float wgt = my_gate * my_sv * 0.5f * a * (1.f + erff(a * 0.70710678118f));
        if (active) gateb[(size_t)t * 128 + (g & 1) * 64 + lane] = wgt;
        idx_c = idx_n; idx_n = idx_nn;
#pragma unroll
        for (int j = 0; j < 16; j++) hp[j] = hq[j];
    }
}
__device__ __forceinline__ void peer_v(const unsigned char* __restrict__ v6, const int* __restrict__ idxb, const float* __restrict__ wgtb,
                            const bf16_t* __restrict__ xb_in, bf16_t* __restrict__ xb_out, float* __restrict__ ssq_out, int bid, int nb, int wv) {
    const int tid = opaque_tid(wv), w = tid >> 6, lane = tid & 63, hl = lane & 31, hh = lane >> 5;
    const int tstride = nb * NW, t0 = bid * NW + w;
    if (t0 >= T) return;
    const int nh = 2 * ((T - 1 - t0) / tstride + 1);
#define VMETA_OFF(g_) ((size_t)(t0 + ((g_) >> 1) * tstride) * 128 + ((g_) & 1) * 64 + lane)
    int idx_c = idxb[VMETA_OFF(0)]; float wgt_c = wgtb[VMETA_OFF(0)];
    int idx_n = idxb[VMETA_OFF(1)]; float wgt_n = wgtb[VMETA_OFF(1)];
    Row6 qa[4], qb[4];
#pragma unroll
    for (int j = 0; j < 4; j++) qa[j] = ld6(v6, sel_half_i(idx_c, j, hh), hl);
#pragma unroll
    for (int j = 0; j < 4; j++) qb[j] = ld6(v6, sel_half_i(idx_c, 4 + j, hh), hl);
    f32x32 acc;
#pragma unroll
    for (int j = 0; j < 32; j++) acc[j] = 0.f;
    int idx_nn = idx_n; float wgt_nn = wgt_n;
    u32x4 xa = (u32x4){0u, 0u, 0u, 0u}, xc = xa;
#pragma unroll
    for (int j = 0; j < 4; j++) asm volatile("" : "+v"(qa[j].a), "+v"(qa[j].b), "+v"(qb[j].a), "+v"(qb[j].b));
    asm volatile("" : "+v"(idx_c), "+v"(wgt_c), "+v"(idx_n), "+v"(wgt_n));
#pragma unroll 1
    for (int g = 0; g < nh; g++) {
        const int t = t0 + (g >> 1) * tstride;
        { const int g2 = min(g + 2, nh - 1); idx_nn = idxb[VMETA_OFF(g2)]; wgt_nn = wgtb[VMETA_OFF(g2)]; }
        if (g & 1) { const bf16_t* xi = xb_in + (size_t)t * DM + hl * 32 + hh * 16; xa = *(const u32x4*)xi; xc = *(const u32x4*)(xi + 8); }
#pragma unroll
        for (int bb = 0; bb < 4; bb++) {
#pragma unroll
            for (int j = 0; j < 4; j++) {
                const float we = sel_half_f(wgt_c, 8 * bb + j, hh);
                const f32x32 d = dec6(qa[j]);
                acc += d * we;
                if (j < 3) asm volatile("" : "+v"(acc), "+v"(qa[j + 1].a)); else asm volatile("" : "+v"(acc));
            }
#pragma unroll
            for (int j = 0; j < 4; j++) qa[j] = ld6(v6, sel_half_i(bb < 3 ? idx_c : idx_n, (8 * bb + 8 + j) & 31, hh), hl);
            __builtin_amdgcn_sched_barrier(0);
#pragma unroll
            for (int j = 0; j < 4; j++) {
                const float we = sel_half_f(wgt_c, 8 * bb + 4 + j, hh);
                const f32x32 d = dec6(qb[j]);
                acc += d * we;
                if (j < 3) asm volatile("" : "+v"(acc), "+v"(qb[j + 1].a)); else asm volatile("" : "+v"(acc));
            }
#pragma unroll
            for (int j = 0; j < 4; j++) qb[j] = ld6(v6, sel_half_i(bb < 3 ? idx_c : idx_n, (8 * bb + 12 + j) & 31, hh), hl);
            __builtin_amdgcn_sched_barrier(0);
        }
        idx_c = idx_n; wgt_c = wgt_n; idx_n = idx_nn; wgt_n = wgt_nn;
        if (g & 1) {
            float mine[16];
#pragma unroll
            for (int k = 0; k < 16; k++) {
                const float lo = acc[k] + bperm(acc[k], lane ^ 32), hi = acc[16 + k] + bperm(acc[16 + k], lane ^ 32);
                mine[k] = hh ? hi : lo;
            }
#pragma unroll
            for (int j = 0; j < 32; j++) acc[j] = 0.f;
            const float xin[16] = {bflo(xa.x), bfhi(xa.x), bflo(xa.y), bfhi(xa.y), bflo(xa.z), bfhi(xa.z), bflo(xa.w), bfhi(xa.w),
                                   bflo(xc.x), bfhi(xc.x), bflo(xc.y), bfhi(xc.y), bflo(xc.z), bfhi(xc.z), bflo(xc.w), bfhi(xc.w)};
            float sq = 0.f; unsigned pk[8];
#pragma unroll
            for (int q4 = 0; q4 < 4; q4++) {
                const f32x4 x = (f32x4){xin[q4 * 4] + mine[q4 * 4], xin[q4 * 4 + 1] + mine[q4 * 4 + 1], xin[q4 * 4 + 2] + mine[q4 * 4 + 2], xin[q4 * 4 + 3] + mine[q4 * 4 + 3]};
                sq += (x[0] * x[0] + x[1] * x[1]) + (x[2] * x[2] + x[3] * x[3]);
                pk[2 * q4] = pack2(x[0], x[1]); pk[2 * q4 + 1] = pack2(x[2], x[3]);
            }
            sq = wave_sum(sq);
            bf16_t* xo = xb_out + (size_t)t * DM + hl * 32 + hh * 16;
            *(u32x4*)xo = (u32x4){pk[0], pk[1], pk[2], pk[3]};
            *(u32x4*)(xo + 8) = (u32x4){pk[4], pk[5], pk[6], pk[7]};
            if (lane < 16) ssq_out[(size_t)t * 16 + lane] = lane == 0 ? sq : 0.f;
        }
    }
}

__device__ const int TJ_IN[11]      = {4, 11, 22, 22, 13, 16, 19, 28, 28, 27, 27};
__device__ const int TJ_SRCOFF[11]  = {0, 0, 0, 1024 * 2048, 0, 0, 0, 0, 1024 * 1024, 0, 256 * 1024};
__device__ const int TJ_GIN[11]     = {3, 10, 21, 21, 12, 15, -1, 26, 26, -1, -1};
__device__ const int TJ_GOFF[11]    = {0, 0, 0, 1024, 0, 0, 0, 0, 1024, 0, 0};
__device__ const int TJ_CUM[12]     = {0, 1600, 2112, 2624, 3136, 3200, 3456, 3712, 3968, 4224, 4288, 4352};
__device__ const int TJ_K[11]       = {1024, 2048, 1024, 1024, 1024, 1024, 1024, 1024, 1024, 256, 256};
__device__ const int TJ_N[11]       = {6176, 1024, 2048, 2048, 256, 1024, 1024, 1024, 1024, 1024, 1024};
__device__ const int TJ_NPAD[11]    = {6400, 1024, 2048, 2048, 256, 1024, 1024, 1024, 1024, 1024, 1024};
__device__ const unsigned TJ_DST[11] = {(unsigned)OFF_W_IN, (unsigned)OFF_W_OUT, (unsigned)OFF_W_PQ, (unsigned)(OFF_W_PQ + 2048 * 1024 * 2), (unsigned)OFF_W_KV, (unsigned)OFF_W_Q, (unsigned)OFF_W_O,
                                        (unsigned)OFF_W_PG, (unsigned)(OFF_W_PG + 1024 * 1024 * 2), (unsigned)OFF_W_PP, (unsigned)(OFF_W_PP + 1024 * 256 * 2)};
constexpr int NPHASES = 22;
constexpr int SMEM_BYTES = 131072 + 8192 + 2048;
static_assert(SMEM_BYTES >= pg8::STAGE_BYTES + 8192 + 2048 && SMEM_BYTES >= 12352 * 4 && SMEM_BYTES >= 256 * RK_LDS * 2 && SMEM_BYTES >= SSD_SMEM && SMEM_BYTES <= 160 * 1024, "smem");

template <int ph> __device__ __forceinline__ void run_phase(const Params& P, int bid, int nb, unsigned char* smem, int wv) {
    unsigned char* ws = P.ws;
    float* smf = (float*)smem; bf16_t* smb = (bf16_t*)smem;
    bf16_t* W_IN = (bf16_t*)(ws + OFF_W_IN); bf16_t* W_OUT = (bf16_t*)(ws + OFF_W_OUT); bf16_t* W_PQ = (bf16_t*)(ws + OFF_W_PQ);
    bf16_t* W_KV = (bf16_t*)(ws + OFF_W_KV); bf16_t* W_Q = (bf16_t*)(ws + OFF_W_Q); bf16_t* W_O = (bf16_t*)(ws + OFF_W_O);
    bf16_t* W_PG = (bf16_t*)(ws + OFF_W_PG); bf16_t* W_PP = (bf16_t*)(ws + OFF_W_PP);
    bf16_t* zx = (bf16_t*)(ws + OFF_Z); float* dtraw = (float*)(ws + OFF_DT); float* ssq = (float*)(ws + OFF_SSQ);
    unsigned char* u8 = ws + OFF_U; unsigned char* v8 = ws + OFF_U + 32 * MiB; float* su = (float*)(ws + OFF_SCL); float* sv = su + 2 * 16384; bf16_t* p_bf = (bf16_t*)(ws + OFF_P);
    bf16_t* xbA = (bf16_t*)(ws + OFF_H); bf16_t* xbB = (bf16_t*)(ws + OFF_V);
    float* ssq0 = (float*)(ws + OFF_SSQP); float* ssq1 = ssq0 + (size_t)T * 16;
    int* idxb = (int*)(ws + OFF_IDX); float* gateb = (float*)(ws + OFF_GATE);
    bf16_t* kvbuf = (bf16_t*)(ws + OFF_KV); bf16_t* aout = (bf16_t*)(ws + OFF_AO);
    bf16_t* obuf = (bf16_t*)P.out;
    int zoff; asm volatile("s_mov_b32 %0, 0" : "=s"(zoff));
    const float* const* in = P.in + zoff;
    switch (ph) {
    case 0:
#pragma unroll 1
        for (int gt = bid; gt < 1600; gt += nb)
            transpose_convert(in[TJ_IN[0]], in[TJ_GIN[0]], TJ_K[0], TJ_N[0], TJ_NPAD[0], (bf16_t*)(ws + TJ_DST[0]), gt, nb, smf, wv);
        convert_x_rows(in[0], obuf, ssq0, bid, nb, wv);
        break;
    case 1: {
        auto tr_rest = [&]() {
#pragma unroll 1
            for (int gt = 1600 + bid; gt < 4352; gt += nb) {
                int j = 1;
#pragma unroll 1
                while (gt >= TJ_CUM[j + 1]) j++;
                const float* src = in[TJ_IN[j]] + TJ_SRCOFF[j];
                const int gi = TJ_GIN[j];
                const float* gain = gi >= 0 ? in[gi] + TJ_GOFF[j] : nullptr;
                transpose_convert(src, gain, TJ_K[j], TJ_N[j], TJ_NPAD[j], (bf16_t*)(ws + TJ_DST[j]), gt - TJ_CUM[j], nb, smf, wv);
            }
        };
        if (bid & 1) tr_rest();
        gemm_phase(obuf, 1024, W_IN, 1024, T, 6144, 1024, EpiInProj{&P, PR_WS(OFF_Z), PR_WS(OFF_DT), PR_WS(OFF_SSQP)}, bid, nb, smb, wv);
        if (!(bid & 1)) tr_rest();
        break; }
    case 2: ssd_chunked(zx, dtraw, in[5], in[6], in[7], in[8], in[9], obuf, ssq, bid, nb, smem, wv); break;
    case 3: break;
    case 4: {
        auto conv = [&]() {
            convert_fp6_rows(in[24], in[21], u8, su, 2 * 16384, bid, nb, wv);
            convert_fp6_rows(in[25], nullptr, v8, sv, 2 * 16384, bid, nb, wv);
            convert_flat(in[1], p_bf, (size_t)2 * T * 256, bid, nb, wv);
        };
        if (bid & 1) conv();
        gemm_phase(obuf, 2048, W_OUT, 2048, T, 1024, 2048, EpiResidY{{&P, PR_IN(0, 0), PR_NUL, PR_NUL, PR_WS(OFF_V), PR_WS(OFF_SSQP + (size_t)T * 16 * 4)}, PR_WS(OFF_SSQ)}, bid, nb, smb, wv);
        if (!(bid & 1)) conv();
        break; }
    case 5: gemm_phase(xbB, 1024, W_PQ, 1024, T, 2048, 1024, EpiBf16{&P, PR_OUT(0), 2048, PR_NUL, 1.f, PR_WS(OFF_SSQP + (size_t)T * 16 * 4)}, bid, nb, smb, wv); break;
    case 6: peer_route_mfma(obuf, in[23], idxb, gateb, bid, nb, smb, wv); break;
    case 7: peer_u(xbB, ssq1, u8, su, sv, idxb, gateb, bid, nb, smf, wv); break;
    case 8: peer_v(v8, idxb, gateb, xbB, xbA, ssq0, bid, nb, wv); break;
    case 9: gemm_phase(p_bf, 256, W_PP, 256, T, 1024, 256, EpiBf16{&P, PR_OUT(0), 1024, PR_NUL, 1.f, PR_NUL}, bid, nb, smb, wv); break;
    case 10: gemm_phase(xbA, 1024, W_PG, 1024, T, 1024, 1024, EpiPle{&P, PR_WS(OFF_H), PR_OUT(0), PR_WS(OFF_SSQP), PR_WS(OFF_V), PR_WS(OFF_SSQP + (size_t)T * 16 * 4)}, bid, nb, smb, wv); break;
    case 11: gemm_phase(xbB, 1024, W_KV, 1024, T, 1280, 1024, EpiKVQ{&P, PR_WS(OFF_KV), PR_OUT(0), PR_IN(14, 0), PR_IN(17, 0), PR_WS(OFF_SSQP + (size_t)T * 16 * 4)}, bid, nb, smb, wv); break;
    case 12: rope_phase(obuf, kvbuf, (const int*)in[2], bid, nb, wv); break;
    case 13: attn_mfma(obuf, kvbuf, in[18], aout, bid, nb, smb, wv); break;
    case 14: gemm_phase(aout, 1024, W_O, 1024, T, 1024, 1024, EpiResid{&P, PR_NUL, PR_WS(OFF_V), PR_IN(20, 0), PR_WS(OFF_H), PR_WS(OFF_SSQP)}, bid, nb, smb, wv); break;
    case 15: gemm_phase(xbA, 1024, W_PQ + (size_t)2048 * 1024, 1024, T, 2048, 1024, EpiBf16{&P, PR_OUT(0), 2048, PR_NUL, 1.f, PR_WS(OFF_SSQP)}, bid, nb, smb, wv); break;
    case 16: peer_route_mfma(obuf, in[23] + 2 * 128 * 128, idxb, gateb, bid, nb, smb, wv); break;
    case 17: peer_u(xbA, ssq0, u8 + (size_t)16384 * ROWB, su + 16384, sv + 16384, idxb, gateb, bid, nb, smf, wv); break;
    case 18: peer_v(v8 + (size_t)16384 * ROWB, idxb, gateb, xbA, xbB, ssq1, bid, nb, wv); break;
    case 19: gemm_phase(p_bf + (size_t)T * 256, 256, W_PP + (size_t)1024 * 256, 256, T, 1024, 256, EpiBf16{&P, PR_OUT(0), 1024, PR_NUL, 1.f, PR_NUL}, bid, nb, smb, wv); break;
    case 20: gemm_phase(xbB, 1024, W_PG + (size_t)1024 * 1024, 1024, T, 1024, 1024, EpiPle{&P, PR_WS(OFF_V), PR_OUT(0), PR_WS(OFF_SSQP + (size_t)T * 16 * 4), PR_WS(OFF_H), PR_WS(OFF_SSQP)}, bid, nb, smb, wv); break;
    case 21: final_norm_rows(xbA, ssq0, in[29], P.out, bid, nb, wv); break;
    default: break;
    }
}

#define XB_TMO      128
#define XB_XCNT(j)  (256  + 64 * (j))
#define XB_XSUB(j)  (1280 + 64 * (j))
#define XB_XGEN(j)  (2304 + 64 * (j))
#define XB_TOP      3328
#define XB_TOPGEN   3392
#define XCD_BAR_WORDS 3456
#define XB_SPIN_CAP (1u << 18)
#define LAS __attribute__((address_space(3)))

__device__ __forceinline__ unsigned xb_ld(unsigned* p)              { return __hip_atomic_load(p, __ATOMIC_RELAXED, __HIP_MEMORY_SCOPE_AGENT); }
__device__ __forceinline__ unsigned xb_add(unsigned* p, unsigned v) { return __hip_atomic_fetch_add(p, v, __ATOMIC_RELAXED, __HIP_MEMORY_SCOPE_AGENT); }
__device__ __forceinline__ unsigned xb_xcc_id() { return (unsigned)__builtin_amdgcn_s_getreg((3 << 11) | 20) & 0xFu; }
#define XB_SPIN(cond, bar) do { unsigned _sp = 0; while (cond) { __builtin_amdgcn_s_sleep(1); \
    if ((++_sp & 255u) == 0u) { if (xb_ld(&(bar)[XB_TMO])) break; if (_sp > XB_SPIN_CAP) { atomicAdd(&(bar)[XB_TMO], 1u); break; } } } } while (0)

struct XcdBarrier {
    unsigned* bar; unsigned x;
    volatile LAS unsigned* st;
};

__device__ __forceinline__ XcdBarrier xcd_barrier_post(unsigned* bar, volatile LAS unsigned* st, bool t0) {
    XcdBarrier b; b.bar = bar; b.x = xb_xcc_id(); b.st = st;
    if (t0) (void)xb_add(&bar[XB_XCNT(b.x)], 1u);
    return b;
}
__device__ __forceinline__ void xcd_barrier_complete(unsigned* bar, unsigned x, unsigned& nloc, unsigned& nx) {
    const unsigned G = gridDim.x * gridDim.y * gridDim.z;
    unsigned sum, cnt, mine, sp = 0u;
    for (;;) {
        sum = 0u; cnt = 0u; mine = 0u;
#pragma unroll
        for (unsigned j = 0; j < 16; ++j) { const unsigned c = xb_ld(&bar[XB_XCNT(j)]); sum += c; cnt += (c > 0u) ? 1u : 0u; mine = (j == x) ? c : mine; }
        if (sum == G) break;
        __builtin_amdgcn_s_sleep(1);
        if ((++sp & 255u) == 0u) { if (xb_ld(&bar[XB_TMO])) break; if (sp > XB_SPIN_CAP) { atomicAdd(&bar[XB_TMO], 1u); break; } }
    }
    nloc = mine > 0u ? mine : 1u; nx = cnt > 0u ? cnt : 1u;
}

__device__ __forceinline__ void xcd_barrier(const XcdBarrier& b, bool t0) {
    asm volatile("s_waitcnt vmcnt(0)" ::: "memory");
    __syncthreads();
    if (t0) {
        unsigned* bar = b.bar;
        __builtin_amdgcn_s_waitcnt(0);
        unsigned nloc = b.st[0], nx = b.st[1];
        if (nloc == 0u) { xcd_barrier_complete(bar, b.x, nloc, nx); b.st[0] = nloc; b.st[1] = nx; }
        const unsigned old = xb_add(&bar[XB_XSUB(b.x)], 1u);
        const unsigned gen = old / nloc;
        if (old + 1u == (gen + 1u) * nloc) {
            __builtin_amdgcn_fence(__ATOMIC_RELEASE, "agent");
            asm volatile("s_waitcnt vmcnt(0)" ::: "memory");
            const unsigned og = xb_add(&bar[XB_TOP], 1u);
            const unsigned tg = og / nx;
            if (og + 1u == (tg + 1u) * nx) xb_add(&bar[XB_TOPGEN], 1u);
            else XB_SPIN(xb_ld(&bar[XB_TOPGEN]) == tg, bar);
            __builtin_amdgcn_fence(__ATOMIC_ACQUIRE, "agent");
            xb_add(&bar[XB_XGEN(b.x)], 1u);
            asm volatile("s_waitcnt vmcnt(0)" ::: "memory");
        } else {
            XB_SPIN(xb_ld(&bar[XB_XGEN(b.x)]) == gen, bar);
            __builtin_amdgcn_fence(__ATOMIC_ACQUIRE, "agent");
            asm volatile("s_waitcnt vmcnt(0)" ::: "memory");
        }
    }
    __syncthreads();
}


#ifdef PROBE_MASK_B
#define PROBE_BUILD 1
#else
#define PROBE_MASK_A 0ull
#define PROBE_MASK_B 0ull
#endif
constexpr bool PROBE = (PROBE_MASK_A | PROBE_MASK_B) != 0ull;
template <int ph> __device__ __forceinline__ void run_all(const Params& P, const XcdBarrier& xb, unsigned char* smem, int wv) {
    if constexpr (ph < NPHASES) {
        if constexpr (ph == 2) {
            bf16_t* zxp = (bf16_t*)(P.ws + opaque_zero() + OFF_Z);
            const BcHalo bh = bc_preact_halo(zxp, blockIdx.x, gridDim.x, wv);
            { unsigned char* wsp = P.ws + opaque_zero();
              dt_minigemm((const bf16_t*)((&P.out)[opaque_zero()]), (const bf16_t*)(wsp + OFF_W_IN) + (size_t)6144 * 1024, (const float*)(wsp + OFF_SSQP), (float*)(wsp + OFF_DT), blockIdx.x, gridDim.x, wv); }
            xcd_barrier(xb, opaque_tid(wv) == 0);
            { const float* const* inp = P.in + opaque_zero(); bc_preact_walk(zxp, inp[5], inp[6], bh, blockIdx.x, gridDim.x, wv); }
            xcd_barrier(xb, opaque_tid(wv) == 0);
        }
        run_phase<ph>(P, blockIdx.x, gridDim.x, smem, wv);
        if constexpr (ph == 5 || ph == 15 || ph == 11) __syncthreads();
        else if constexpr (ph + 1 < NPHASES && ph != 3 && ph != 7 && ph != 8 && ph != 17 && ph != 18) xcd_barrier(xb, opaque_tid(wv) == 0);
        run_all<ph + 1>(P, xb, smem, wv);
    }
}

__global__ void __launch_bounds__(NTHREADS, 2) fwd_megakernel(Params P) {
    __shared__ __attribute__((aligned(16))) unsigned char smem[SMEM_BYTES + 16];
    const int wv = __builtin_amdgcn_readfirstlane(threadIdx.x >> 6);
    if (blockIdx.x == 0) {
        unsigned* bar0 = (unsigned*)(P.ws + OFF_BAR);
        for (int i = threadIdx.x; i < XCD_BAR_WORDS; i += NTHREADS) __hip_atomic_store(&bar0[i], 0u, __ATOMIC_RELAXED, __HIP_MEMORY_SCOPE_AGENT);
        __threadfence();
    }
    cg::this_grid().sync();
    volatile LAS unsigned* xst = (volatile LAS unsigned*)(LAS unsigned char*)(smem + SMEM_BYTES);
    if (opaque_tid(wv) == 0) { xst[0] = 0u; xst[1] = 0u; }
    __syncthreads();
    const XcdBarrier xb = xcd_barrier_post((unsigned*)(P.ws + OFF_BAR), xst, opaque_tid(wv) == 0);
    run_all<0>(P, xb, smem, wv);
}

#ifdef PROBE_BUILD
template <int ph> __device__ __forceinline__ void run_sel(const Params& P, int sel, unsigned char* smem, int wv) {
    if constexpr (ph < NPHASES) { if (sel == ph) run_phase<ph>(P, blockIdx.x, gridDim.x, smem, wv); run_sel<ph + 1>(P, sel, smem, wv); }
}
__global__ void __launch_bounds__(NTHREADS, 2) k_sel(Params P, int sel) {
    __shared__ __attribute__((aligned(16))) unsigned char smem[SMEM_BYTES + 16];
    const int wv = __builtin_amdgcn_readfirstlane(threadIdx.x >> 6);
    if (blockIdx.x == 0 && threadIdx.x == 0) ((unsigned long long*)P.ws)[sel] = __builtin_amdgcn_s_memrealtime();
    if (sel == 100) { bf16_t* zxp = (bf16_t*)(P.ws + OFF_Z); const BcHalo bh = bc_preact_halo(zxp, blockIdx.x, gridDim.x, wv);
        dt_minigemm((const bf16_t*)P.out, (const bf16_t*)(P.ws + OFF_W_IN) + (size_t)6144 * 1024, (const float*)(P.ws + OFF_SSQP), (float*)(P.ws + OFF_DT), blockIdx.x, gridDim.x, wv); bc_preact_walk(zxp, P.in[5], P.in[6], bh, blockIdx.x, gridDim.x, wv); return; }
    run_sel<0>(P, sel, smem, wv);
}
static void launch_phases(const Params& P, int grid, hipStream_t stream) {
    for (int sel = 0; sel < NPHASES; sel++) {
        if (sel == 2) hipLaunchKernelGGL(k_sel, dim3(grid), dim3(NTHREADS), 0, stream, P, 100);
        hipLaunchKernelGGL(k_sel, dim3(grid), dim3(NTHREADS), 0, stream, P, sel);
    }
}
__global__ void __launch_bounds__(256) probe_post(Params P) {
    unsigned long long* ts = (unsigned long long*)P.ws;
    if (blockIdx.x == 0 && threadIdx.x == 0) { ts[NPHASES] = __builtin_amdgcn_s_memrealtime(); __threadfence(); }
    __syncthreads();
    if (blockIdx.x != 0) return;
    const float total = (float)(ts[NPHASES] - ts[0]); float b = 0.f;
    for (int k = 0; k < NPHASES; k++) { const float d = (float)(ts[k + 1] - ts[k]); if ((PROBE_MASK_B >> k) & 1ull) b += d; }
    const float VB = 100.f * b / total;
    for (size_t i = threadIdx.x; i < (size_t)2048 * 1024; i += 256) {
        float v = P.out[i] + 0.5f; if (i == 0) v += VB + 8.f; P.out[i] = v;
    }
}

#endif

extern "C" void kernel_launch(void* const* d_in, const int* in_sizes, int n_in, void* d_out, int out_size, void* d_ws, size_t ws_size, hipStream_t stream) {
    if (n_in != 30 || ws_size < WS_END) { fprintf(stderr, "kernel_launch: unexpected n_in %d / ws_size %zu (need %zu)\n", n_in, ws_size, (size_t)WS_END); return; }
    static int grid_blocks = 0;
    if (!grid_blocks) {
        int dev = 0, cus = 0, per_cu = 0;
        hipGetDevice(&dev);
        hipDeviceGetAttribute(&cus, hipDeviceAttributeMultiprocessorCount, dev);
        hipOccupancyMaxActiveBlocksPerMultiprocessor(&per_cu, fwd_megakernel, NTHREADS, 0);
        if (per_cu > 1) per_cu = 1;
        if (per_cu < 1) per_cu = 1;
        grid_blocks = cus * per_cu;
        fprintf(stderr, "kernel_launch: cus %d per_cu %d grid %d\n", cus, per_cu, grid_blocks);
    }
    Params P{};
    for (int i = 0; i < 30; i++) P.in[i] = (const float*)d_in[i];
    P.out = (float*)d_out; P.ws = (unsigned char*)d_ws;
#ifdef PROBE_BUILD
    launch_phases(P, grid_blocks, stream); hipLaunchKernelGGL(probe_post, dim3(1), dim3(256), 0, stream, P); return;
#endif
    void* args[] = {&P};
    hipError_t e = hipLaunchCooperativeKernel((void*)fwd_megakernel, dim3(grid_blocks), dim3(NTHREADS), args, 0, stream);
    if (e != hipSuccess) fprintf(stderr, "cooperative launch failed: %s (grid %d)\n", hipGetErrorString(e), grid_blocks);
}
```

```cpp
#include <hip/hip_runtime.h>
#include <hip/hip_cooperative_groups.h>
#include <stdint.h>
#include <stdio.h>
namespace cg = cooperative_groups;

typedef unsigned short bf16_t;
typedef short bf16x8 __attribute__((ext_vector_type(8)));
typedef float f32x4 __attribute__((ext_vector_type(4)));
typedef unsigned u32x4 __attribute__((ext_vector_type(4)));
typedef unsigned u32x2 __attribute__((ext_vector_type(2)));
typedef float f32x16 __attribute__((ext_vector_type(16)));

constexpr int T = 32768;
constexpr int SEQ = 4096;
constexpr int DM = 1024;
constexpr int NTHREADS = 512;
constexpr int NW = NTHREADS / 64;

constexpr size_t MiB = 1u << 20;
constexpr size_t OFF_BAR   = 64 * 1024;
constexpr size_t OFF_SCL   = 128 * 1024;
constexpr size_t OFF_W_IN  = 1 * MiB;
constexpr size_t OFF_W_OUT = OFF_W_IN  + (size_t)6400 * 1024 * 2;
constexpr size_t OFF_W_PQ  = OFF_W_OUT + (size_t)1024 * 2048 * 2;
constexpr size_t OFF_W_KV  = OFF_W_PQ  + (size_t)2 * 2048 * 1024 * 2;
constexpr size_t OFF_W_Q   = OFF_W_KV  + (size_t)256 * 1024 * 2;
constexpr size_t OFF_W_O   = OFF_W_Q   + (size_t)1024 * 1024 * 2;
constexpr size_t OFF_W_PG  = OFF_W_O   + (size_t)1024 * 1024 * 2;
constexpr size_t OFF_W_PP  = OFF_W_PG  + (size_t)2 * 1024 * 1024 * 2;
constexpr size_t OFF_W_END = OFF_W_PP  + (size_t)2 * 1024 * 256 * 2;
static_assert(OFF_W_END <= 40 * MiB, "weights region");
constexpr size_t OFF_Z     = 40 * MiB;
constexpr size_t OFF_DT    = OFF_Z + 384 * MiB;
constexpr size_t OFF_SSQ   = OFF_DT + 4 * MiB;
constexpr size_t OFF_U     = OFF_Z;
constexpr size_t OFF_V     = OFF_Z + 64 * MiB;
constexpr size_t OFF_P     = OFF_Z + 128 * MiB;
constexpr size_t OFF_XRES  = OFF_Z + 160 * MiB;
constexpr size_t OFF_H     = OFF_Z + 288 * MiB;
constexpr size_t OFF_IDX   = OFF_Z + 352 * MiB;
constexpr size_t OFF_GATE  = OFF_Z + 368 * MiB;
constexpr size_t OFF_KV    = OFF_Z + 384 * MiB;
constexpr size_t OFF_AO    = OFF_Z + 400 * MiB;
constexpr size_t OFF_SSQP  = OFF_Z + 464 * MiB;
constexpr size_t WS_END    = OFF_Z + 468 * MiB;
static_assert(WS_END <= 512 * MiB, "workspace");

struct Params {
    const float* in[30];
    float* out;
    unsigned char* ws;
};

__device__ __forceinline__ bf16_t f2bf(float f) { unsigned u = __float_as_uint(f); u += 0x7fffu + ((u >> 16) & 1u); return (bf16_t)(u >> 16); }
__device__ __forceinline__ float bf2f(bf16_t h) { return __uint_as_float(((unsigned)h) << 16); }
typedef __bf16 hw_bf16x2 __attribute__((ext_vector_type(2)));
typedef float hw_f32x2 __attribute__((ext_vector_type(2)));
__device__ __forceinline__ unsigned pack2(float lo, float hi) { const hw_f32x2 v = {lo, hi}; return __builtin_bit_cast(unsigned, __builtin_convertvector(v, hw_bf16x2)); }
__device__ __forceinline__ float bflo(unsigned u) { return __uint_as_float(u << 16); }
__device__ __forceinline__ float bfhi(unsigned u) { return __uint_as_float(u & 0xffff0000u); }
template <int X> __device__ __forceinline__ float swz_xor(float v) { return __int_as_float(__builtin_amdgcn_ds_swizzle(__float_as_int(v), 0x1f | (X << 10))); }
__device__ __forceinline__ float bperm(float v, int srclane) { return __int_as_float(__builtin_amdgcn_ds_bpermute(srclane << 2, __float_as_int(v))); }
__device__ __forceinline__ float rl_f(float v, int l) { return __uint_as_float((unsigned)__builtin_amdgcn_readlane((int)__float_as_uint(v), l)); }
template <int N> __device__ __forceinline__ float dpp_row_ror(float v) {
    return __int_as_float(__builtin_amdgcn_update_dpp(0, __float_as_int(v), 0x120 + N, 0xf, 0xf, true));
}
__device__ __forceinline__ float wave_sum(float v) { v += dpp_row_ror<8>(v); v += dpp_row_ror<4>(v); v += dpp_row_ror<2>(v); v += dpp_row_ror<1>(v); return (rl_f(v, 0) + rl_f(v, 16)) + (rl_f(v, 32) + rl_f(v, 48)); }
__device__ __forceinline__ float wave_max(float v) { v = fmaxf(v, dpp_row_ror<8>(v)); v = fmaxf(v, dpp_row_ror<4>(v)); v = fmaxf(v, dpp_row_ror<2>(v)); v = fmaxf(v, dpp_row_ror<1>(v)); return fmaxf(fmaxf(rl_f(v, 0), rl_f(v, 16)), fmaxf(rl_f(v, 32), rl_f(v, 48))); }
__device__ __forceinline__ int opaque_tid(int wv) { int t = (wv << 6) | (int)__builtin_amdgcn_mbcnt_hi(~0u, __builtin_amdgcn_mbcnt_lo(~0u, 0u)); asm volatile("" : "+v"(t)); return t; }
__device__ __forceinline__ float silu_f(float a) { return a * __builtin_amdgcn_rcpf(1.f + __expf(-a)); }

__device__ __forceinline__ void transpose_convert(const float* __restrict__ src, const float* __restrict__ gain, int K, int N, int Npad, bf16_t* __restrict__ dst, int bid, int nb, float* sm, int wv) {
    const int tilesK = K / 64, tid = opaque_tid(wv);
    {
        const int tile = bid; (void)nb; (void)Npad;
        const int tk = tile % tilesK, tn = tile / tilesK, k0 = tk * 64, n0 = tn * 64;
#pragma unroll
        for (int i = 0; i < 2; i++) {
            const int kr = (tid >> 4) + 32 * i, nc = (tid & 15) * 4;
            float4 v = make_float4(0.f, 0.f, 0.f, 0.f);
            if (n0 + nc < N) v = *(const float4*)(src + (size_t)(k0 + kr) * N + n0 + nc);
            if (gain) { const float gk = gain[k0 + kr]; v.x *= gk; v.y *= gk; v.z *= gk; v.w *= gk; }
            sm[kr * 65 + nc + 0] = v.x; sm[kr * 65 + nc + 1] = v.y; sm[kr * 65 + nc + 2] = v.z; sm[kr * 65 + nc + 3] = v.w;
        }
        __syncthreads();
        {
            const int n = tid >> 3, kc = (tid & 7) * 8;
            unsigned o[4];
#pragma unroll
            for (int j = 0; j < 4; j++) o[j] = pack2(sm[(kc + 2 * j) * 65 + n], sm[(kc + 2 * j + 1) * 65 + n]);
            bf16_t* d = dst + (size_t)(n0 + n) * K + k0 + kc;
            *(u32x4*)d = (u32x4){o[0], o[1], o[2], o[3]};
        }
        __syncthreads();
    }
}

__device__ __forceinline__ void convert_flat(const float* __restrict__ src, bf16_t* __restrict__ dst, size_t n, int bid, int nb, int wv) {
    const size_t nvec = n / 8; const int tid = opaque_tid(wv);
    for (size_t i = (size_t)bid * NTHREADS + tid; i < nvec; i += (size_t)nb * NTHREADS) {
        const float4 a = ((const float4*)src)[2 * i], b = ((const float4*)src)[2 * i + 1];
        ((u32x4*)dst)[i] = (u32x4){pack2(a.x, a.y), pack2(a.z, a.w), pack2(b.x, b.y), pack2(b.z, b.w)};
    }
}

typedef float f32x2 __attribute__((ext_vector_type(2)));
constexpr int ROWB = 768;
__device__ __forceinline__ unsigned fp6_code(float x, float inv) {
    const float ax = fminf(fabsf(x) * inv, 7.5f);
    unsigned mag;
    if (ax < 1.f) mag = (unsigned)__float2int_rn(ax * 8.f);
    else { unsigned u = __float_as_uint(ax); u += 0x7FFFFu + ((u >> 20) & 1u); mag = ((((u >> 23) - 127u) + 1u) << 3) | ((u >> 20) & 7u); }
    mag = mag > 31u ? 31u : mag;
    return mag | (x < 0.f ? 32u : 0u);
}
__device__ __forceinline__ void convert_fp6_rows(const float* __restrict__ src, const float* __restrict__ gain  , unsigned char* __restrict__ dst, float* __restrict__ scale, int R, int bid, int nb, int wv) {
    const int tid = opaque_tid(wv), wave = tid >> 6, lane = tid & 63;
    for (int row = bid * NW + wave; row < R; row += nb * NW) {
        const float4* sr = (const float4*)(src + (size_t)row * 1024 + lane * 16);
        float v[16]; float m = 0.f;
#pragma unroll
        for (int i = 0; i < 4; i++) {
            float4 t = sr[i];
            if (gain) { const float4 gg = *(const float4*)(gain + (size_t)(row >> 14) * 1024 + lane * 16 + i * 4); t.x *= gg.x; t.y *= gg.y; t.z *= gg.z; t.w *= gg.w; }
            v[4 * i] = t.x; v[4 * i + 1] = t.y; v[4 * i + 2] = t.z; v[4 * i + 3] = t.w;
            m = fmaxf(m, fmaxf(fmaxf(fabsf(t.x), fabsf(t.y)), fmaxf(fabsf(t.z), fabsf(t.w))));
        }
        m = wave_max(m);
        const float inv = m > 0.f ? 7.5f / m : 0.f;
        unsigned c[16];
#pragma unroll
        for (int j = 0; j < 16; j++) c[j] = fp6_code(v[j], inv);
        const unsigned d0 = c[0] | (c[1] << 6) | (c[2] << 12) | (c[3] << 18) | (c[4] << 24) | (c[5] << 30);
        const unsigned d1 = (c[5] >> 2) | (c[6] << 4) | (c[7] << 10) | (c[8] << 16) | (c[9] << 22) | (c[10] << 28);
        const unsigned d2 = (c[10] >> 4) | (c[11] << 2) | (c[12] << 8) | (c[13] << 14) | (c[14] << 20) | (c[15] << 26);
        unsigned char* rp = dst + (size_t)row * ROWB; const int L = lane >> 1;
        if ((lane & 1) == 0) { unsigned* p = (unsigned*)(rp + L * 16); p[0] = d0; p[1] = d1; p[2] = d2; }
        else { *(unsigned*)(rp + L * 16 + 12) = d0; unsigned* p = (unsigned*)(rp + 512 + L * 8); p[0] = d1; p[1] = d2; }
        if (lane == 0) scale[row] = m * (1.f / 7.5f);
    }
}

__device__ __forceinline__ float row_rscale(const float* __restrict__ ssq, size_t row) {
    const f32x4* p = (const f32x4*)(ssq + row * 16);
    const f32x4 a = p[0], b = p[1], c = p[2], d = p[3];
    const float sum = (((a[0] + a[1]) + (a[2] + a[3])) + ((b[0] + b[1]) + (b[2] + b[3]))) + (((c[0] + c[1]) + (c[2] + c[3])) + ((d[0] + d[1]) + (d[2] + d[3])));
    return rsqrtf(sum * (1.f / DM) + 1e-6f);
}
__device__ __forceinline__ void convert_x_rows(const float* __restrict__ x, bf16_t* __restrict__ xb, float* __restrict__ ssq, int bid, int nb, int wv) {
    const int tid = opaque_tid(wv), wave = tid >> 6, lane = tid & 63;
    for (int row = bid * NW + wave; row < T; row += nb * NW) {
        const float4* xr = (const float4*)(x + (size_t)row * DM);
        float ss = 0.f;
#pragma unroll
        for (int i = 0; i < 4; i++) {
            const float4 v = xr[i * 64 + lane]; ss += v.x * v.x + v.y * v.y + v.z * v.z + v.w * v.w;
            *(u32x2*)(xb + (size_t)row * DM + (i * 64 + lane) * 4) = (u32x2){pack2(v.x, v.y), pack2(v.z, v.w)};
        }
        ss = wave_sum(ss);
        if (lane < 16) ssq[(size_t)row * 16 + lane] = lane == 0 ? ss : 0.f;
    }
}
__device__ __forceinline__ void final_norm_rows(const bf16_t* __restrict__ x, const float* __restrict__ ssq, const float* __restrict__ g, float* __restrict__ out, int bid, int nb, int wv) {
    const int tid = opaque_tid(wv), wave = tid >> 6, lane = tid & 63;
    for (int row = bid * NW + wave; row < T; row += nb * NW) {
        const float r = row_rscale(ssq, (size_t)row);
#pragma unroll
        for (int i = 0; i < 4; i++) {
            const u32x2 xv = *(const u32x2*)(x + (size_t)row * DM + (i * 64 + lane) * 4); const float4 v = make_float4(bflo(xv.x), bfhi(xv.x), bflo(xv.y), bfhi(xv.y)); const float4 gg = ((const float4*)g)[i * 64 + lane];
            ((float4*)(out + (size_t)row * DM))[i * 64 + lane] = make_float4(v.x * r * gg.x, v.y * r * gg.y, v.z * r * gg.z, v.w * r * gg.w);
        }
    }
}

namespace pg8 {
#define PG8_LAS __attribute__((address_space(3)))
typedef unsigned short bf16_t;
typedef short bf16x8 __attribute__((ext_vector_type(8)));
typedef float f32x4 __attribute__((ext_vector_type(4)));
typedef unsigned u32x4 __attribute__((ext_vector_type(4)));
constexpr int BM = 256, BK = 64, HALF = 128, HTB = HALF * BK * 2  , STAGE_BYTES = 8 * HTB, NXCD = 8, WGM = 8;

__host__ __device__ __forceinline__ int lds_byte(int r, int c) { const int st = (r >> 4) * 2 + (c >> 5), rr = r & 15, cc = c & 31, ob = rr * 64 + cc * 2; return st * 1024 + (ob ^ (((ob >> 9) & 1) << 5)); }
__host__ __device__ __forceinline__ void stage_rc(int b, int& R, int& C) { const int st = b / 1024, sb = b % 1024, swz = sb ^ (((sb >> 9) & 1) << 5); R = (st >> 1) * 16 + swz / 64; C = (st & 1) * 32 + (swz % 64) / 2; }
__host__ __device__ __forceinline__ int perm32(int rho) { const int n = rho >> 4, i = rho & 15; return 8 * (i >> 2) + 4 * n + (i & 3); }

struct Unit { int pm, pn; };
struct Gemm { const bf16_t* A; const bf16_t* Bt; int M, N, K; };

struct StaticOrder {
    int nM, nN, nwg, G, c;
    __host__ __device__ void init(int M, int N, int G_, int c_) { nM = M / BM; nN = N / BM; nwg = nM * nN; G = G_; c = c_; }
    __host__ __device__ bool next(int i, Unit& u) const {
        const long L = (long)i * G + c; if (L >= nwg) return false;
        int wgid = (int)L; { const int q = nwg / NXCD, r = nwg % NXCD, xcd = wgid % NXCD, off = wgid / NXCD; wgid = (xcd < r ? xcd * (q + 1) : r * (q + 1) + (xcd - r) * q) + off; }
        const int nig = WGM * nN, gid = wgid / nig, fm = gid * WGM, gsz = (nM - fm) < WGM ? (nM - fm) : WGM;
        u.pm = fm + ((wgid % nig) % gsz); u.pn = (wgid % nig) / gsz; return true;
    }
    __device__ __forceinline__ void a_ready(const Unit&) const {}
    __device__ __forceinline__ void done(const Unit&) const {}
};

template <class Epi, class Sched, bool ALIGN_EPI = false, bool SP2 = false>
__device__ __forceinline__ void gemm_phase(PG8_LAS unsigned char* lds, const Gemm g, const Sched& S, const Epi& E, int wv) {
    const int tid = opaque_tid(wv), wid = __builtin_amdgcn_readfirstlane(tid >> 6), lane = tid & 63, wr = wid >> 2, wc = wid & 3, fr = lane & 15, fq = lane >> 4;
    const int K = g.K, nt = K / BK;
    unsigned voffA[2], voffB[2];
#pragma unroll
    for (int i = 0; i < 2; ++i) { int R, C; stage_rc(tid * 16 + i * 8192, R, C); const int Rb = Epi::PERM ? ((R & ~31) + perm32(R & 31)) : R;
        voffA[i] = (unsigned)(R * K + C) * 2u; voffB[i] = (unsigned)(Rb * K + C) * 2u; }
    const size_t kstep = (size_t)(BK * 2);
    const size_t hstep = (size_t)HALF * K * 2;
    const size_t tstep = 2 * hstep;
    const unsigned ldsw = (unsigned)wid * 1024u;
    const int aoff = lds_byte(wr * 64 + fr, fq * 8), boff = lds_byte(wc * 32 + fr, fq * 8);
#define PG8_SA(b, h) (((b) * 2 + (h)) * HTB)
#define PG8_SB(b, h) ((4 + (b) * 2 + (h)) * HTB)
#define PG8_STAGE(bufoff, gbase, voff) do { _Pragma("unroll") for (int _i = 0; _i < 2; ++_i) \
        __builtin_amdgcn_global_load_lds((const unsigned*)((const char*)(gbase) + (voff)[_i]), (PG8_LAS unsigned*)(lds + (bufoff) + ldsw + _i * 8192), 16, 0, 0); } while (0)
#define PG8_LDA(dst, b, h) do { _Pragma("unroll") for (int m = 0; m < 4; ++m) _Pragma("unroll") for (int k = 0; k < 2; ++k) dst[m][k] = *(const PG8_LAS bf16x8*)(lds + PG8_SA(b, h) + aoff + m * 2048 + k * 1024); } while (0)
#define PG8_LDB(dst, b, h) do { _Pragma("unroll") for (int n = 0; n < 2; ++n) _Pragma("unroll") for (int k = 0; k < 2; ++k) dst[n][k] = *(const PG8_LAS bf16x8*)(lds + PG8_SB(b, h) + boff + n * 2048 + k * 1024); } while (0)
#define PG8_MMA(ai, bj, At, Bt) do { __builtin_amdgcn_s_setprio(1); _Pragma("unroll") for (int m = 0; m < 4; ++m) _Pragma("unroll") for (int n = 0; n < 2; ++n) _Pragma("unroll") for (int k = 0; k < 2; ++k) \
        acc[ai][bj][m][n] = __builtin_amdgcn_mfma_f32_16x16x32_bf16(Bt[n][k], At[m][k], acc[ai][bj][m][n], 0, 0, 0); __builtin_amdgcn_s_setprio(0); } while (0)
#define PG8_WAIT_V(n) asm volatile("s_waitcnt vmcnt(" #n ")" ::: "memory")
#define PG8_WAIT_L(n) asm volatile("s_waitcnt lgkmcnt(" #n ")" ::: "memory")
#define PG8_BAR __builtin_amdgcn_s_barrier()
#define PG8_SCHED __builtin_amdgcn_sched_barrier(0)
    Unit cur, nxt; int ui = 0;
    if (!S.next(0, cur)) return;
    f32x4 acc[2][2][4][2];
#pragma unroll
    for (int a = 0; a < 2; ++a)
#pragma unroll
        for (int b = 0; b < 2; ++b)
#pragma unroll
            for (int m = 0; m < 4; ++m)
#pragma unroll
                for (int n = 0; n < 2; ++n) acc[a][b][m][n] = (f32x4){0.f, 0.f, 0.f, 0.f};
    bf16x8 At[4][2], B0[2][2], B1[2][2];
    const char* cA = (const char*)g.A + (size_t)cur.pm * tstep; const char* cB = (const char*)g.Bt + (size_t)cur.pn * tstep;
    S.a_ready(cur);
    if constexpr (Epi::KSCALE) E.kfill(lds + STAGE_BYTES, cur, opaque_tid(wv));
    if constexpr (SP2) {
        PG8_STAGE(PG8_SB(0, 0), cB, voffB); PG8_STAGE(PG8_SB(0, 1), cB + hstep, voffB); PG8_STAGE(PG8_SA(0, 0), cA, voffA); PG8_STAGE(PG8_SA(0, 1), cA + hstep, voffA);
        if (wr == 1) PG8_BAR;
        PG8_WAIT_V(2); PG8_BAR;
        PG8_STAGE(PG8_SB(1, 0), cB + kstep, voffB); PG8_STAGE(PG8_SA(1, 0), cA + kstep, voffA); PG8_STAGE(PG8_SB(1, 1), cB + hstep + kstep, voffB);
        PG8_WAIT_V(6); PG8_BAR;
    } else {
        PG8_STAGE(PG8_SB(0, 0), cB, voffB); PG8_STAGE(PG8_SA(0, 0), cA, voffA); PG8_STAGE(PG8_SB(0, 1), cB + hstep, voffB); PG8_STAGE(PG8_SA(0, 1), cA + hstep, voffA);
        if (wr == 1) PG8_BAR;
        PG8_WAIT_V(4); PG8_BAR;
        PG8_STAGE(PG8_SB(1, 0), cB + kstep, voffB); PG8_STAGE(PG8_SA(1, 0), cA + kstep, voffA); PG8_STAGE(PG8_SB(1, 1), cB + hstep + kstep, voffB);
        PG8_WAIT_V(6); PG8_BAR;
    }
    for (;;) {
        const bool has_next = S.next(ui + 1, nxt);
        const char* nA = has_next ? (const char*)g.A + (size_t)nxt.pm * tstep : cA; const char* nB = has_next ? (const char*)g.Bt + (size_t)nxt.pn * tstep : cB;
#pragma unroll 1
        for (int t = 0; t < nt; t += 2) {
            const bool last = (t == nt - 2);
            const char* a1 = cA + (size_t)(t + 1) * kstep;
            const char* a2 = last ? nA : cA + (size_t)(t + 2) * kstep; const char* b2 = last ? nB : cB + (size_t)(t + 2) * kstep;
            const char* a3 = a2 + kstep; const char* b3 = b2 + kstep;
            if (last && has_next) S.a_ready(nxt);
            if constexpr (Epi::KSCALE) { if ((t & 3) == 0 && t > 0) {
                const int gq = (t >> 2) - 1;
                PG8_LAS const unsigned char* qb_ = lds + STAGE_BYTES + (gq * 256 + wr * 64 + (opaque_tid(wv) & 15)) * 4;
#pragma unroll
                for (int ai = 0; ai < 2; ++ai)
#pragma unroll
                    for (int m = 0; m < 4; ++m) {
                        const float q = *(const PG8_LAS float*)(qb_ + (ai * 128 + m * 16) * 4);
#pragma unroll
                        for (int bj = 0; bj < 2; ++bj)
#pragma unroll
                            for (int n = 0; n < 2; ++n) acc[ai][bj][m][n] *= q;
                        asm volatile("" ::: "memory");
                    }
            } }
            if constexpr (SP2) {
            PG8_LDB(B0, 0, 0); PG8_LDB(B1, 0, 1); PG8_SCHED; PG8_LDA(At, 0, 0); PG8_STAGE(PG8_SA(1, 1), a1 + hstep, voffA);
            PG8_WAIT_V(8); PG8_WAIT_L(0); PG8_BAR; PG8_MMA(0, 0, At, B0); PG8_MMA(0, 1, At, B1); PG8_BAR; PG8_SCHED;
            PG8_LDA(At, 0, 1); PG8_STAGE(PG8_SB(0, 0), b2, voffB); PG8_STAGE(PG8_SB(0, 1), b2 + hstep, voffB); PG8_STAGE(PG8_SA(0, 0), a2, voffA);
            PG8_WAIT_V(8); PG8_WAIT_L(0); PG8_BAR; PG8_MMA(1, 0, At, B0); PG8_MMA(1, 1, At, B1); PG8_BAR; PG8_SCHED;
            PG8_LDB(B0, 1, 0); PG8_LDB(B1, 1, 1); PG8_SCHED; PG8_LDA(At, 1, 0); PG8_STAGE(PG8_SA(0, 1), a2 + hstep, voffA);
            PG8_WAIT_V(8); PG8_WAIT_L(0); PG8_BAR; PG8_MMA(0, 0, At, B0); PG8_MMA(0, 1, At, B1); PG8_BAR; PG8_SCHED;
            PG8_LDA(At, 1, 1); PG8_STAGE(PG8_SB(1, 0), b3, voffB); PG8_STAGE(PG8_SB(1, 1), b3 + hstep, voffB); PG8_STAGE(PG8_SA(1, 0), a3, voffA);
            PG8_WAIT_V(8); PG8_WAIT_L(0); PG8_BAR; PG8_MMA(1, 0, At, B0); PG8_MMA(1, 1, At, B1); PG8_BAR; PG8_SCHED;
            } else {
            PG8_LDB(B0, 0, 0); PG8_SCHED; PG8_LDA(At, 0, 0); PG8_STAGE(PG8_SA(1, 1), a1 + hstep, voffA);
            PG8_WAIT_L(8); PG8_BAR; PG8_WAIT_L(0); PG8_MMA(0, 0, At, B0); PG8_BAR; PG8_SCHED;
            PG8_LDB(B1, 0, 1); PG8_STAGE(PG8_SB(0, 0), b2, voffB);
            PG8_BAR; PG8_WAIT_L(0); PG8_MMA(0, 1, At, B1); PG8_BAR;
            PG8_LDA(At, 0, 1); PG8_STAGE(PG8_SA(0, 0), a2, voffA);
            PG8_BAR; PG8_WAIT_L(0); PG8_MMA(1, 0, At, B0); PG8_BAR; PG8_SCHED;
            PG8_STAGE(PG8_SB(0, 1), b2 + hstep, voffB);
            PG8_WAIT_V(6); PG8_BAR; PG8_MMA(1, 1, At, B1); PG8_BAR;
            PG8_LDB(B0, 1, 0); PG8_SCHED; PG8_LDA(At, 1, 0); PG8_STAGE(PG8_SA(0, 1), a2 + hstep, voffA);
            PG8_WAIT_L(8); PG8_BAR; PG8_WAIT_L(0); PG8_MMA(0, 0, At, B0); PG8_BAR; PG8_SCHED;
            PG8_LDB(B1, 1, 1); PG8_STAGE(PG8_SB(1, 0), b3, voffB);
            PG8_BAR; PG8_WAIT_L(0); PG8_MMA(0, 1, At, B1); PG8_BAR;
            PG8_LDA(At, 1, 1); PG8_STAGE(PG8_SA(1, 0), a3, voffA);
            PG8_BAR; PG8_WAIT_L(0); PG8_MMA(1, 0, At, B0); PG8_BAR; PG8_SCHED;
            PG8_STAGE(PG8_SB(1, 1), b3 + hstep, voffB);
            PG8_WAIT_V(6); PG8_BAR; PG8_MMA(1, 1, At, B1); PG8_BAR;
            }
        }
        if constexpr (Epi::KSCALE) {
            PG8_LAS const unsigned char* qb_ = lds + STAGE_BYTES + (((nt >> 2) - 1) * 256 + wr * 64 + (opaque_tid(wv) & 15)) * 4;
#pragma unroll
            for (int ai = 0; ai < 2; ++ai)
#pragma unroll
                for (int m = 0; m < 4; ++m) {
                    const float q = *(const PG8_LAS float*)(qb_ + (ai * 128 + m * 16) * 4);
#pragma unroll
                    for (int bj = 0; bj < 2; ++bj)
#pragma unroll
                        for (int n = 0; n < 2; ++n) acc[ai][bj][m][n] *= q;
                    asm volatile("" ::: "memory");
                }
        }
        if constexpr (ALIGN_EPI) { if (wr == 0) PG8_BAR; }
        if constexpr (!Epi::AFTER_DRAIN) { E(acc, cur, wr, wc, fr, fq); S.done(cur); }
        if constexpr (Epi::KSCALE) { if (has_next) E.kfill(lds + STAGE_BYTES, nxt, opaque_tid(wv)); }
        if (!has_next) break;
#pragma unroll
        for (int a = 0; a < 2; ++a)
#pragma unroll
            for (int b = 0; b < 2; ++b)
#pragma unroll
                for (int m = 0; m < 4; ++m)
#pragma unroll
                    for (int n = 0; n < 2; ++n) acc[a][b][m][n] = (f32x4){0.f, 0.f, 0.f, 0.f};
        cur = nxt; cA = nA; cB = nB; ++ui;
        if constexpr (ALIGN_EPI) { if (wr == 1) PG8_BAR; }
    }
    PG8_WAIT_V(0);
    if constexpr (!ALIGN_EPI) { if (wr == 0) PG8_BAR; }
    PG8_BAR;
    if constexpr (Epi::AFTER_DRAIN) { E.fused(acc, cur, wr, wc, fr, fq, lds, wid, lane); S.done(cur); }
#undef PG8_SA
#undef PG8_SB
#undef PG8_STAGE
#undef PG8_LDA
#undef PG8_LDB
#undef PG8_MMA
#undef PG8_WAIT_V
#undef PG8_WAIT_L
#undef PG8_BAR
#undef PG8_SCHED
}
}

typedef pg8::Unit GUnit;
#ifndef GEMM_SP2
#define GEMM_SP2 true
#endif
struct PRef { int kind; long off; };
#define PR_NUL (PRef{-2, 0})
#define PR_WS(off_) (PRef{-1, (long)(off_)})
#define PR_OUT(off_) (PRef{-3, (long)(off_)})
#define PR_IN(k_, off_) (PRef{(k_), (long)(off_)})
__device__ __forceinline__ int opaque_zero() { int z; asm volatile("s_mov_b32 %0, 0" : "=s"(z)); return z; }
template <class Tp> __device__ __forceinline__ Tp* pr_resolve(const Params& P, const PRef r, int z) {
    if (r.kind == -2) return (Tp*)nullptr;
    if (r.kind == -1) return (Tp*)((&P.ws)[z] + r.off);
    if (r.kind == -3) return (Tp*)((unsigned char*)((&P.out)[z]) + r.off);
    return (Tp*)((const unsigned char*)(P.in[r.kind + z]) + r.off);
}
#define EPI_ROWS_BEGIN const int row0 = u.pm * 256 + wr * 64 + fr, col00 = u.pn * 256 + wc * 32 + 8 * fq; \
    _Pragma("unroll") for (int ai = 0; ai < 2; ++ai) _Pragma("unroll") for (int m = 0; m < 4; ++m) { const size_t row = (size_t)(row0 + ai * 128 + m * 16); asm volatile("" ::: "memory");
#define EPI_ROWS_END }
#define EPI_ROW_SCALES(ssq_in) float rr_[2][4]; { const int row0_ = u.pm * 256 + wr * 64 + fr; f32x4 pq_[2][4]; \
    _Pragma("unroll") for (int ai = 0; ai < 2; ++ai) _Pragma("unroll") for (int m = 0; m < 4; ++m) \
        pq_[ai][m] = (ssq_in) ? *(const f32x4*)((ssq_in) + (size_t)(row0_ + ai * 128 + m * 16) * 16 + fq * 4) : (f32x4){0.f, 0.f, 0.f, 0.f}; \
    _Pragma("unroll") for (int ai = 0; ai < 2; ++ai) _Pragma("unroll") for (int m = 0; m < 4; ++m) { \
        float s_ = (pq_[ai][m][0] + pq_[ai][m][1]) + (pq_[ai][m][2] + pq_[ai][m][3]); s_ += swz_xor<16>(s_); s_ += bperm(s_, (fq * 16 + fr) ^ 32); \
        rr_[ai][m] = (ssq_in) ? rsqrtf(s_ * (1.f / DM) + 1e-6f) : 1.f; } }
#define EPI_SSQ_STORE(ssq_out, sq) do { float s_ = (sq); s_ += swz_xor<16>(s_); s_ += bperm(s_, (fq * 16 + fr) ^ 32); if (fq == 0) (ssq_out)[row * 16 + u.pn * 4 + wc] = s_; } while (0)
struct EpiInProj {
    static constexpr bool PERM = true, AFTER_DRAIN = false, KSCALE = false;
    const Params* P; PRef zx_, dtraw_, ssq_in_;
    __device__ __forceinline__ void operator()(const f32x4 (&acc)[2][2][4][2], const GUnit& u, int wr, int wc, int fr, int fq) const {
        const int z = opaque_zero(); bf16_t* zx = pr_resolve<bf16_t>(*P, zx_, z); float* dtraw = pr_resolve<float>(*P, dtraw_, z); const float* ssq_in = pr_resolve<const float>(*P, ssq_in_, z);
        EPI_ROW_SCALES(ssq_in)
        EPI_ROWS_BEGIN
            const float r = rr_[ai][m];
#pragma unroll
            for (int bj = 0; bj < 2; ++bj) {
                const int col = col00 + bj * 128; const f32x4 v0 = acc[ai][bj][m][0] * r, v1 = acc[ai][bj][m][1] * r;
                if (col < 6144) *(u32x4*)(zx + row * 6144 + col) = (u32x4){pack2(v0[0], v0[1]), pack2(v0[2], v0[3]), pack2(v1[0], v1[1]), pack2(v1[2], v1[3])};
                else if (col < 6176) { *(f32x4*)(dtraw + row * 32 + (col - 6144)) = v0; *(f32x4*)(dtraw + row * 32 + (col - 6144) + 4) = v1; }
            }
        EPI_ROWS_END
    }
};
struct EpiResid {
    static constexpr bool PERM = true, AFTER_DRAIN = false, KSCALE = false;
    const Params* P; PRef resid32_, residb_, bias_, xb_, ssq_out_;
    __device__ __forceinline__ void operator()(const f32x4 (&acc)[2][2][4][2], const GUnit& u, int wr, int wc, int fr, int fq) const {
        const int z = opaque_zero(); const float* resid32 = pr_resolve<const float>(*P, resid32_, z); const bf16_t* residb = pr_resolve<const bf16_t>(*P, residb_, z); const float* bias = pr_resolve<const float>(*P, bias_, z);
        bf16_t* xb = pr_resolve<bf16_t>(*P, xb_, z); float* ssq_out = pr_resolve<float>(*P, ssq_out_, z);
        f32x4 nrs[2][2];
        f32x4 bv_[2][2];
        { const int row0_ = u.pm * 256 + wr * 64 + fr, col0_ = u.pn * 256 + wc * 32 + 8 * fq;
#pragma unroll
          for (int bj = 0; bj < 2; ++bj) {
              if (bias) { bv_[bj][0] = *(const f32x4*)(bias + col0_ + bj * 128); bv_[bj][1] = *(const f32x4*)(bias + col0_ + bj * 128 + 4); } else { bv_[bj][0] = bv_[bj][1] = (f32x4){0.f, 0.f, 0.f, 0.f}; }
              if (resid32) { nrs[bj][0] = *(const f32x4*)(resid32 + (size_t)row0_ * DM + col0_ + bj * 128); nrs[bj][1] = *(const f32x4*)(resid32 + (size_t)row0_ * DM + col0_ + bj * 128 + 4); }
              else { nrs[bj][0] = __builtin_bit_cast(f32x4, *(const u32x4*)(residb + (size_t)row0_ * DM + col0_ + bj * 128)); nrs[bj][1] = nrs[bj][0]; } } }
        EPI_ROWS_BEGIN
            float sq = 0.f;
            const f32x4 crs[2][2] = {{nrs[0][0], nrs[0][1]}, {nrs[1][0], nrs[1][1]}};
            if (ai * 4 + m < 7) { const size_t rn = (size_t)(row0 + ((ai * 4 + m + 1) >> 2) * 128 + ((ai * 4 + m + 1) & 3) * 16);
#pragma unroll
                for (int bj = 0; bj < 2; ++bj) {
                    if (resid32) { nrs[bj][0] = *(const f32x4*)(resid32 + rn * DM + col00 + bj * 128); nrs[bj][1] = *(const f32x4*)(resid32 + rn * DM + col00 + bj * 128 + 4); }
                    else { nrs[bj][0] = __builtin_bit_cast(f32x4, *(const u32x4*)(residb + rn * DM + col00 + bj * 128)); } } }
            asm volatile("" ::: "memory");
#pragma unroll
            for (int bj = 0; bj < 2; ++bj) {
                const int col = col00 + bj * 128; f32x4 v0 = acc[ai][bj][m][0], v1 = acc[ai][bj][m][1];
                v0 += bv_[bj][0]; v1 += bv_[bj][1];
                if (resid32) { v0 += crs[bj][0]; v1 += crs[bj][1]; }
                else { const u32x4 rb = __builtin_bit_cast(u32x4, crs[bj][0]);
                       v0 += (f32x4){bflo(rb.x), bfhi(rb.x), bflo(rb.y), bfhi(rb.y)}; v1 += (f32x4){bflo(rb.z), bfhi(rb.z), bflo(rb.w), bfhi(rb.w)}; }
                *(u32x4*)(xb + row * DM + col) = (u32x4){pack2(v0[0], v0[1]), pack2(v0[2], v0[3]), pack2(v1[0], v1[1]), pack2(v1[2], v1[3])};
                sq += (v0[0] * v0[0] + v0[1] * v0[1]) + (v0[2] * v0[2] + v0[3] * v0[3]) + (v1[0] * v1[0] + v1[1] * v1[1]) + (v1[2] * v1[2] + v1[3] * v1[3]);
                asm volatile("" ::: "memory");
            }
            EPI_SSQ_STORE(ssq_out, sq);
        EPI_ROWS_END
    }
};
struct EpiResidY : EpiResid {
    static constexpr bool KSCALE = true;
    PRef ssqh_;
    __device__ __forceinline__ void kfill(PG8_LAS unsigned char* tab, const GUnit& u, int tid) const {
        const float* ssqh = pr_resolve<const float>(*P, ssqh_, opaque_zero());
        const int lr = tid & 255, hf = tid >> 8;
        const float* sp = ssqh + (size_t)(u.pm * 256 + lr) * 32 + hf * 16;
        float r[5];
#pragma unroll
        for (int g = 0; g < 5; g++) {
            const f32x4 s4 = *(const f32x4*)(sp + ((hf == 1 && g == 4) ? 12 : g * 4));
            r[g] = rsqrtf((s4[0] + s4[1] + s4[2] + s4[3]) * (1.f / 256.f) + 1e-5f);
        }
#pragma unroll
        for (int g = 0; g < 4; g++) {
            const float q = (hf == 1 && g == 3) ? r[3] : r[g] / r[g + 1];
            *(PG8_LAS float*)(tab + ((hf * 4 + g) * 256 + lr) * 4) = q;
        }
    }
};
struct EpiBf16 {
    static constexpr bool PERM = true, AFTER_DRAIN = false, KSCALE = false;
    const Params* P; PRef out_; int ldc; PRef bias_; float scale; PRef ssq_in_;
    __device__ __forceinline__ void operator()(const f32x4 (&acc)[2][2][4][2], const GUnit& u, int wr, int wc, int fr, int fq) const {
        const int z = opaque_zero(); bf16_t* out = pr_resolve<bf16_t>(*P, out_, z); const float* bias = pr_resolve<const float>(*P, bias_, z); const float* ssq_in = pr_resolve<const float>(*P, ssq_in_, z);
        EPI_ROW_SCALES(ssq_in)
        EPI_ROWS_BEGIN
            const float r = rr_[ai][m];
#pragma unroll
            for (int bj = 0; bj < 2; ++bj) {
                const int col = col00 + bj * 128; f32x4 v0 = acc[ai][bj][m][0] * r, v1 = acc[ai][bj][m][1] * r;
                if (bias) { v0 += *(const f32x4*)(bias + col); v1 += *(const f32x4*)(bias + col + 4); }
                v0 *= scale; v1 *= scale;
                *(u32x4*)(out + row * ldc + col) = (u32x4){pack2(v0[0], v0[1]), pack2(v0[2], v0[3]), pack2(v1[0], v1[1]), pack2(v1[2], v1[3])};
            }
        EPI_ROWS_END
    }
};
struct EpiKVQ {
    static constexpr bool PERM = true, AFTER_DRAIN = false, KSCALE = false;
    const Params* P; PRef kvbuf_, qatt_, kv_b_, q_b_, ssq_in_;
    __device__ __forceinline__ void operator()(const f32x4 (&acc)[2][2][4][2], const GUnit& u, int wr, int wc, int fr, int fq) const {
        const int z = opaque_zero(); bf16_t* kvbuf = pr_resolve<bf16_t>(*P, kvbuf_, z); bf16_t* qatt = pr_resolve<bf16_t>(*P, qatt_, z);
        const float* kv_b = pr_resolve<const float>(*P, kv_b_, z); const float* q_b = pr_resolve<const float>(*P, q_b_, z); const float* ssq_in = pr_resolve<const float>(*P, ssq_in_, z);
        const bool isq = u.pn > 0;
        const float* bias = isq ? q_b - 256 : kv_b; bf16_t* outp = isq ? qatt - 256 : kvbuf; const int ldc = isq ? 1024 : 256; const float scale = isq ? 0.125f : 1.f;
        EPI_ROW_SCALES(ssq_in)
        f32x4 bv_[2][2];
        { const int col0_ = u.pn * 256 + wc * 32 + 8 * fq;
#pragma unroll
          for (int bj = 0; bj < 2; ++bj) { bv_[bj][0] = *(const f32x4*)(bias + col0_ + bj * 128); bv_[bj][1] = *(const f32x4*)(bias + col0_ + bj * 128 + 4); } }
        EPI_ROWS_BEGIN
            const float r = rr_[ai][m];
#pragma unroll
            for (int bj = 0; bj < 2; ++bj) {
                const int col = col00 + bj * 128; f32x4 v0 = acc[ai][bj][m][0] * r, v1 = acc[ai][bj][m][1] * r;
                v0 += bv_[bj][0]; v1 += bv_[bj][1];
                v0 *= scale; v1 *= scale;
                *(u32x4*)(outp + row * ldc + col) = (u32x4){pack2(v0[0], v0[1]), pack2(v0[2], v0[3]), pack2(v1[0], v1[1]), pack2(v1[2], v1[3])};
            }
        EPI_ROWS_END
    }
};
struct EpiPle {
    static constexpr bool PERM = true, AFTER_DRAIN = false, KSCALE = false;
    const Params* P; PRef xin_, tmp_, ssq_in_, xb_, ssq_out_;
    __device__ __forceinline__ void operator()(const f32x4 (&acc)[2][2][4][2], const GUnit& u, int wr, int wc, int fr, int fq) const {
        const int z = opaque_zero(); const bf16_t* xin = pr_resolve<const bf16_t>(*P, xin_, z); const bf16_t* tmp = pr_resolve<const bf16_t>(*P, tmp_, z); const float* ssq_in = pr_resolve<const float>(*P, ssq_in_, z);
        bf16_t* xb = pr_resolve<bf16_t>(*P, xb_, z); float* ssq_out = pr_resolve<float>(*P, ssq_out_, z);
        EPI_ROW_SCALES(ssq_in)
        u32x4 ntb, nxb;
        { const int row0_ = u.pm * 256 + wr * 64 + fr, col0_ = u.pn * 256 + wc * 32 + 8 * fq;
          ntb = *(const u32x4*)(tmp + (size_t)row0_ * DM + col0_); nxb = *(const u32x4*)(xin + (size_t)row0_ * DM + col0_); }
        EPI_ROWS_BEGIN
            const float r = rr_[ai][m];
            float sq = 0.f;
#pragma unroll
            for (int bj = 0; bj < 2; ++bj) {
                const int col = col00 + bj * 128; const f32x4 v0 = acc[ai][bj][m][0] * r, v1 = acc[ai][bj][m][1] * r;
                const u32x4 tb = ntb; const u32x4 xbv = nxb;
                { const int jn = (ai * 4 + m) * 2 + bj + 1;
                  if (jn < 16) { const size_t rn = (size_t)(row0 + ((jn >> 1) >> 2) * 128 + ((jn >> 1) & 3) * 16); const int cn = col00 + (jn & 1) * 128;
                                 ntb = *(const u32x4*)(tmp + rn * DM + cn); nxb = *(const u32x4*)(xin + rn * DM + cn); } }
                asm volatile("" ::: "memory");
                f32x4 x0 = (f32x4){bflo(xbv.x), bfhi(xbv.x), bflo(xbv.y), bfhi(xbv.y)}, x1 = (f32x4){bflo(xbv.z), bfhi(xbv.z), bflo(xbv.w), bfhi(xbv.w)};
                x0[0] += bflo(tb.x) * __builtin_amdgcn_rcpf(1.f + __expf(-v0[0])); x0[1] += bfhi(tb.x) * __builtin_amdgcn_rcpf(1.f + __expf(-v0[1]));
                x0[2] += bflo(tb.y) * __builtin_amdgcn_rcpf(1.f + __expf(-v0[2])); x0[3] += bfhi(tb.y) * __builtin_amdgcn_rcpf(1.f + __expf(-v0[3]));
                x1[0] += bflo(tb.z) * __builtin_amdgcn_rcpf(1.f + __expf(-v1[0])); x1[1] += bfhi(tb.z) * __builtin_amdgcn_rcpf(1.f + __expf(-v1[1]));
                x1[2] += bflo(tb.w) * __builtin_amdgcn_rcpf(1.f + __expf(-v1[2])); x1[3] += bfhi(tb.w) * __builtin_amdgcn_rcpf(1.f + __expf(-v1[3]));
                *(u32x4*)(xb + row * DM + col) = (u32x4){pack2(x0[0], x0[1]), pack2(x0[2], x0[3]), pack2(x1[0], x1[1]), pack2(x1[2], x1[3])};
                sq += (x0[0] * x0[0] + x0[1] * x0[1]) + (x0[2] * x0[2] + x0[3] * x0[3]) + (x1[0] * x1[0] + x1[1] * x1[1]) + (x1[2] * x1[2] + x1[3] * x1[3]);
                asm volatile("" ::: "memory");
            }
            EPI_SSQ_STORE(ssq_out, sq);
        EPI_ROWS_END
    }
};
template <class Epi>
__device__ __forceinline__ void gemm_phase(const bf16_t* A, int lda, const bf16_t* Bt, int ldb, int M, int N, int K, const Epi& epi, int bid, int nb, bf16_t* sm, int wv) {
    pg8::Gemm g{A, Bt, M, N, K};
    pg8::StaticOrder S; S.init(M, N, nb, bid);
    pg8::gemm_phase<Epi, pg8::StaticOrder, true, GEMM_SP2>((PG8_LAS unsigned char*)sm, g, S, epi, wv);
    __syncthreads();
}

constexpr int S_LC = 136, S_LT = 72;
constexpr int SSD_OFF_C = 0, SSD_OFF_B = SSD_OFF_C + 64 * S_LC * 2, SSD_OFF_BT = SSD_OFF_B + 64 * S_LC * 2, SSD_OFF_XD = SSD_OFF_BT + 128 * S_LT * 2,
              SSD_OFF_XDD = SSD_OFF_XD + 64 * S_LT * 2, SSD_OFF_M = SSD_OFF_XDD + 64 * S_LT * 2, SSD_OFF_F = SSD_OFF_M + 64 * S_LT * 2, SSD_OFF_CW = SSD_OFF_F + (2 * 5 * 64 + 4 * 64) * 4, SSD_SMEM = SSD_OFF_CW + 40 * 41 * 4;
template <int N> __device__ __forceinline__ float dpp_row_shr0(float v) {
    return __int_as_float(__builtin_amdgcn_update_dpp(0, __float_as_int(v), 0x110 + N, 0xf, 0xf, false));
}
#define SSD_FILL_F(dst, chunk_) do { float* d_ = (dst); const float v_ = dtv_next + dtb; const float e_ = __expf(-fabsf(v_)); \
    const float dt_ = fmaxf(v_, 0.f) + (e_ < 0.001f ? e_ * (1.f - 0.5f * e_) : __logf(1.f + e_)); float cs_ = dt_ * Aneg; \
    cs_ += dpp_row_shr0<1>(cs_); cs_ += dpp_row_shr0<2>(cs_); cs_ += dpp_row_shr0<4>(cs_); cs_ += dpp_row_shr0<8>(cs_); \
    { const float r0_ = rl_f(cs_, 15), r1_ = rl_f(cs_, 31), r2_ = rl_f(cs_, 47); cs_ += ((lane >= 16 ? r0_ : 0.f) + (lane >= 32 ? r1_ : 0.f)) + (lane >= 48 ? r2_ : 0.f); } \
    const float cl_ = rl_f(cs_, 63); d_[lane] = dt_; d_[64 + lane] = cs_; d_[128 + lane] = __expf(cs_); d_[192 + lane] = __expf(cl_ - cs_); d_[256 + lane] = 1.f / dt_; } while (0)
__device__ __forceinline__ float elem8(const u32x4& v, int c) { const unsigned u = c < 2 ? v.x : c < 4 ? v.y : c < 6 ? v.z : v.w; return (c & 1) ? bfhi(u) : bflo(u); }
__device__ __forceinline__ void dt_minigemm(const bf16_t* __restrict__ xb, const bf16_t* __restrict__ wt, const float* __restrict__ ssq_in, float* __restrict__ dtraw, int bid, int nb, int wv) {
    const int tid = opaque_tid(wv), w = tid >> 6, lane = tid & 63, l15 = lane & 15, quad = lane >> 4;
    for (int grp = bid * NW + w; grp < T / 16; grp += nb * NW) {
        const bf16_t* ap = xb + (size_t)(grp * 16 + l15) * DM + quad * 8;
        const bf16_t* bp = wt + (size_t)l15 * DM + quad * 8;
        f32x4 acc0 = (f32x4){0.f, 0.f, 0.f, 0.f}, acc1 = acc0;
#pragma unroll 8
        for (int s = 0; s < 32; s++) {
            const bf16x8 a = *(const bf16x8*)(ap + s * 32), b0 = *(const bf16x8*)(bp + s * 32), b1 = *(const bf16x8*)(bp + 16 * DM + s * 32);
            acc0 = __builtin_amdgcn_mfma_f32_16x16x32_bf16(a, b0, acc0, 0, 0, 0);
            acc1 = __builtin_amdgcn_mfma_f32_16x16x32_bf16(a, b1, acc1, 0, 0, 0);
        }
#pragma unroll
        for (int i = 0; i < 4; i++) {
            const size_t row = (size_t)grp * 16 + quad * 4 + i;
            const float r = row_rscale(ssq_in, row);
            dtraw[row * 32 + l15] = acc0[i] * r; dtraw[row * 32 + 16 + l15] = acc1[i] * r;
        }
    }
}
struct BcHalo { u32x4 r0, r1, r2; };
__device__ __forceinline__ int bc_nseg(int nb) { int n = 64; while (n > 1 && 8 * n * 256 > nb * NTHREADS) n >>= 1; return n; }
__device__ __forceinline__ BcHalo bc_preact_halo(const bf16_t* zx, int bid, int nb, int wv) {
    const int gt = bid * NTHREADS + opaque_tid(wv), nseg = bc_nseg(nb), seglen = SEQ / nseg;
    BcHalo h; h.r0 = h.r1 = h.r2 = (u32x4){0u, 0u, 0u, 0u};
    if (gt < 8 * nseg * 256) {
        const int strip = gt & 255, sg = (gt >> 8) % nseg, b = (gt >> 8) / nseg, s0 = sg * seglen;
        if (s0 > 0) {
            const bf16_t* p = zx + ((size_t)b * SEQ + s0 - 3) * 6144 + 4096 + strip * 8;
            h.r0 = *(const u32x4*)p; h.r1 = *(const u32x4*)(p + 6144); h.r2 = *(const u32x4*)(p + 2 * 6144);
        }
    }
    return h;
}
__device__ __forceinline__ void bc_preact_walk(bf16_t* zx, const float* __restrict__ conv_w, const float* __restrict__ conv_b, const BcHalo& h, int bid, int nb, int wv) {
    const int gt = bid * NTHREADS + opaque_tid(wv), nseg = bc_nseg(nb), seglen = SEQ / nseg;
    if (gt >= 8 * nseg * 256) return;
    const int strip = gt & 255, sg = (gt >> 8) % nseg, b = (gt >> 8) / nseg, s0 = sg * seglen;
    float wt[8][5];
#pragma unroll
    for (int c = 0; c < 8; c++) {
#pragma unroll
        for (int k = 0; k < 4; k++) wt[c][k] = conv_w[k * 4096 + 2048 + strip * 8 + c];
        wt[c][4] = conv_b[2048 + strip * 8 + c];
    }
    bf16_t* p = zx + ((size_t)b * SEQ + s0) * 6144 + 4096 + strip * 8;
    float f0[8], f1[8], f2[8];
#pragma unroll
    for (int c = 0; c < 8; c++) { f0[c] = elem8(h.r0, c); f1[c] = elem8(h.r1, c); f2[c] = elem8(h.r2, c); }
    u32x4 cur[4];
#pragma unroll
    for (int j = 0; j < 4; j++) cur[j] = *(const u32x4*)(p + (size_t)j * 6144);
#pragma unroll 1
    for (int r = 0; r < seglen; r += 4) {
        u32x4 nxt[4];
        const int rn = r + 4 < seglen ? r + 4 : r;
#pragma unroll
        for (int j = 0; j < 4; j++) nxt[j] = *(const u32x4*)(p + (size_t)(rn + j) * 6144);
#pragma unroll
        for (int j = 0; j < 4; j++) {
            const u32x4 row = cur[j];
            unsigned pk[4]; float oprev = 0.f;
#pragma unroll
            for (int c = 0; c < 8; c++) {
                const float f3 = elem8(row, c);
                const float o = silu_f(wt[c][4] + wt[c][0] * f0[c] + wt[c][1] * f1[c] + wt[c][2] * f2[c] + wt[c][3] * f3);
                if (c & 1) pk[c >> 1] = pack2(oprev, o); else oprev = o;
                f0[c] = f1[c]; f1[c] = f2[c]; f2[c] = f3;
            }
            *(u32x4*)(p + (size_t)(r + j) * 6144) = (u32x4){pk[0], pk[1], pk[2], pk[3]};
            asm volatile("" ::: "memory");
        }
#pragma unroll
        for (int j = 0; j < 4; j++) cur[j] = nxt[j];
    }
}
__device__ __forceinline__ void ssd_chunked(const bf16_t* __restrict__ zx, const float* __restrict__ dtraw, const float* __restrict__ conv_w, const float* __restrict__ conv_b,
                        const float* __restrict__ dt_bias, const float* __restrict__ A_log, const float* __restrict__ Dskip,
                        bf16_t* __restrict__ ybuf, float* __restrict__ ssq, int bid, int nb, unsigned char* smem, int wv) {
    bf16_t* Cs = (bf16_t*)(smem + SSD_OFF_C); bf16_t* Bs = (bf16_t*)(smem + SSD_OFF_B); bf16_t* BTs = (bf16_t*)(smem + SSD_OFF_BT);
    bf16_t* XdT = (bf16_t*)(smem + SSD_OFF_XD); bf16_t* XddT = (bf16_t*)(smem + SSD_OFF_XDD); bf16_t* Ms = (bf16_t*)(smem + SSD_OFF_M);
    float* fbuf = (float*)(smem + SSD_OFF_F); float* part = fbuf + 2 * 320;
    float* cwl = (float*)(smem + SSD_OFF_CW);
    const int tid = opaque_tid(wv), lane = tid & 63, w = tid >> 6, l15 = lane & 15, quad = lane >> 4, pq = w & 3, lh = w >> 2;
    for (int item = bid; item < 256; item += nb) {
        const int b = item >> 5, head = item & 31, g = head >> 2;
        const float Aneg = -__expf(A_log[head]), dtb = dt_bias[head], Dh = Dskip[head];
        const bool xt = tid < 256;
        const int cgl = xt ? (tid & 7) : ((tid - 256) & 15);
        const int isC = xt ? 0 : ((tid - 256) >> 4) & 1;
        const int tgp = xt ? (tid >> 3) : ((tid - 256) >> 5);
        const int rbase = xt ? tgp * 2 - 3 : tgp * 8;
        const int col = xt ? 2048 + head * 64 + cgl * 8 : 4096 + isC * 1024 + g * 128 + cgl * 8;
        for (int i = tid; i < 5 * 64; i += NTHREADS) {
            const int k = i / 64, lc = i % 64;
            cwl[(lc >> 3) * 41 + (lc & 7) * 5 + k] = k < 4 ? conv_w[k * 4096 + head * 64 + lc] : conv_b[head * 64 + lc];
        }
        const float* cwp = cwl + (xt ? cgl : 0) * 41;
        f32x4 Hacc[8];
#pragma unroll
        for (int nt = 0; nt < 8; nt++) Hacc[nt] = (f32x4){0.f, 0.f, 0.f, 0.f};
        float dtv_next = 0.f;
        if (w == 7) dtv_next = dtraw[((size_t)b * SEQ + lane) * 32 + head];
        u32x4 rawn[8];
#pragma unroll
        for (int j = 0; j < 8; j++) {
            rawn[j] = (u32x4){0u, 0u, 0u, 0u};
            if (!xt || j < 5) {
                const int srow = rbase + j;
                const u32x4 rv = *(const u32x4*)(zx + ((size_t)b * SEQ + (srow < 0 ? 0 : srow)) * 6144 + col);
                rawn[j] = srow >= 0 ? rv : (u32x4){0u, 0u, 0u, 0u};
            }
        }
        for (int ck = 0; ck < 64; ck++) {
            const int s0 = ck * 64;
            const size_t t0 = (size_t)b * SEQ + s0;
            float* fdt = fbuf + (ck & 1) * 320; float* fcs = fdt + 64; float* fecs = fcs + 64; float* fwl = fecs + 64; float* fidt = fwl + 64;
            if (ck == 0 && w == 7) { SSD_FILL_F(fbuf, 0); dtv_next = dtraw[(t0 + 64 + lane) * 32 + head]; }
            __syncthreads();
            if (ck > 0 && tid < 64) ssq[(t0 - 64 + tid) * 32 + head] = part[tid] + part[64 + tid] + part[128 + tid] + part[192 + tid];
            if (w == 7 && ck + 1 < 64) { SSD_FILL_F(fbuf + ((ck + 1) & 1) * 320, ck + 1); if (ck + 2 < 64) dtv_next = dtraw[(t0 + 128 + lane) * 32 + head]; }
            if (xt) {
                const f32x2 dl = *(const f32x2*)(fdt + 2 * tgp), wl2 = *(const f32x2*)(fwl + 2 * tgp);
#pragma unroll
                for (int c = 0; c < 8; c++) {
                    const float w0 = cwp[c * 5], w1 = cwp[c * 5 + 1], w2 = cwp[c * 5 + 2], w3 = cwp[c * 5 + 3], bb = cwp[c * 5 + 4];
                    float e[5];
#pragma unroll
                    for (int j = 0; j < 5; j++) e[j] = elem8(rawn[j], c);
                    const float o0 = silu_f(bb + w0 * e[0] + w1 * e[1] + w2 * e[2] + w3 * e[3]) * dl[0];
                    const float o1 = silu_f(bb + w0 * e[1] + w1 * e[2] + w2 * e[3] + w3 * e[4]) * dl[1];
                    const int pos = (cgl * 8 + c) * S_LT + (((tgp >> 2) ^ (cgl & 7)) * 8 + (tgp & 3) * 2);
                    *(unsigned*)(XdT + pos) = pack2(o0, o1);
                    *(unsigned*)(XddT + pos) = pack2(o0 * wl2[0], o1 * wl2[1]);
                }
            } else {
                bf16_t* rowmaj = isC ? Cs : Bs;
#pragma unroll
                for (int j = 0; j < 8; j++) *(u32x4*)(rowmaj + (tgp * 8 + j) * S_LC + cgl * 8) = rawn[j];
                if (!isC) {
#pragma unroll
                    for (int hf = 0; hf < 2; hf++)
#pragma unroll
                        for (int c = 0; c < 8; c++) {
#define SSD_W(v_) ((c) < 2 ? (v_).x : (c) < 4 ? (v_).y : (c) < 6 ? (v_).z : (v_).w)
                            const unsigned sel = (c & 1) ? 0x07060302u : 0x05040100u;
                            const unsigned p01 = __builtin_amdgcn_perm(SSD_W(rawn[hf * 4 + 1]), SSD_W(rawn[hf * 4 + 0]), sel);
                            const unsigned p23 = __builtin_amdgcn_perm(SSD_W(rawn[hf * 4 + 3]), SSD_W(rawn[hf * 4 + 2]), sel);
                            *(u32x2*)(BTs + (cgl * 8 + c) * S_LT + ((tgp ^ (cgl & 7)) * 8 + hf * 4)) = (u32x2){p01, p23};
                        }
                }
            }
            if (ck + 1 < 64) {
#pragma unroll
                for (int j = 0; j < 8; j++) if (!xt || j < 5) rawn[j] = *(const u32x4*)(zx + (t0 + 64 + rbase + j) * 6144 + col);
            }
            bf16_t zreg[2][4];
#pragma unroll
            for (int h2 = 0; h2 < 2; h2++)
#pragma unroll
                for (int r = 0; r < 4; r++) zreg[h2][r] = zx[(t0 + (2 * lh + h2) * 16 + quad * 4 + r) * 6144 + head * 64 + pq * 16 + l15];
            __syncthreads();
            {
                const int lt = w & 3;
#pragma unroll
                for (int h2 = 0; h2 < 2; h2++) {
                    const int st = 2 * (w >> 2) + h2;
                    f32x4 gacc = (f32x4){0.f, 0.f, 0.f, 0.f};
                    if (st <= lt) {
#pragma unroll
                        for (int ks = 0; ks < 4; ks++) {
                            const bf16x8 a = *(const bf16x8*)(Bs + (st * 16 + l15) * S_LC + ks * 32 + quad * 8);
                            const bf16x8 bb = *(const bf16x8*)(Cs + (lt * 16 + l15) * S_LC + ks * 32 + quad * 8);
                            gacc = __builtin_amdgcn_mfma_f32_16x16x32_bf16(a, bb, gacc, 0, 0, 0);
                        }
                        const int l = lt * 16 + l15; const float csl = fcs[l];
#pragma unroll
                        for (int r = 0; r < 4; r++) { const int sidx = st * 16 + quad * 4 + r; gacc[r] = sidx <= l ? gacc[r] * __expf(csl - fcs[sidx]) : 0.f; }
                    }
                    *(u32x2*)(Ms + (lt * 16 + l15) * S_LT + st * 16 + quad * 4) = (u32x2){pack2(gacc[0], gacc[1]), pack2(gacc[2], gacc[3])};
                }
            }
            __syncthreads();
            bf16x8 hb[4];
#pragma unroll
            for (int s4 = 0; s4 < 4; s4++) {
                const u32x4 pk = (u32x4){pack2(Hacc[2 * s4][0], Hacc[2 * s4][1]), pack2(Hacc[2 * s4][2], Hacc[2 * s4][3]),
                                         pack2(Hacc[2 * s4 + 1][0], Hacc[2 * s4 + 1][1]), pack2(Hacc[2 * s4 + 1][2], Hacc[2 * s4 + 1][3])};
                hb[s4] = __builtin_bit_cast(bf16x8, pk);
            }
#pragma unroll
            for (int h2 = 0; h2 < 2; h2++) {
                const int lt = 2 * lh + h2;
                f32x4 yd = (f32x4){0.f, 0.f, 0.f, 0.f}, yo = (f32x4){0.f, 0.f, 0.f, 0.f};
#pragma unroll
                for (int ks = 0; ks < 2; ks++) {
                    if (ks == 0 || lt >= 2) {
                        const bf16x8 a = *(const bf16x8*)(Ms + (lt * 16 + l15) * S_LT + ks * 32 + quad * 8);
                        const bf16x8 bb = *(const bf16x8*)(XdT + (pq * 16 + l15) * S_LT + (((ks * 4 + quad) ^ ((pq * 2 + (l15 >> 3)) & 7)) * 8));
                        yd = __builtin_amdgcn_mfma_f32_16x16x32_bf16(a, bb, yd, 0, 0, 0);
                    }
                }
#pragma unroll
                for (int s4 = 0; s4 < 4; s4++) {
                    const u32x2 c0 = *(const u32x2*)(Cs + (lt * 16 + l15) * S_LC + s4 * 32 + quad * 4);
                    const u32x2 c1 = *(const u32x2*)(Cs + (lt * 16 + l15) * S_LC + s4 * 32 + 16 + quad * 4);
                    const bf16x8 a = __builtin_bit_cast(bf16x8, ((u32x4){c0.x, c0.y, c1.x, c1.y}));
                    yo = __builtin_amdgcn_mfma_f32_16x16x32_bf16(a, hb[s4], yo, 0, 0, 0);
                }
                const int p = pq * 16 + l15, lb = lt * 16 + quad * 4;
                const u32x2 xw = *(const u32x2*)(XdT + p * S_LT + ((((lb >> 3) ^ ((p >> 3) & 7)) * 8) + (lb & 7)));
                const float xdv[4] = {bflo(xw.x), bfhi(xw.x), bflo(xw.y), bfhi(xw.y)};
                float sq[4];
#pragma unroll
                for (int r = 0; r < 4; r++) {
                    const int l = lb + r;
                    const float yv = yd[r] + fecs[l] * yo[r] + Dh * xdv[r] * fidt[l];
                    const float zv = bf2f(zreg[h2][r]);
                    const float yg = yv * silu_f(zv);
                    ybuf[(t0 + l) * 2048 + head * 64 + p] = f2bf(yg);
                    float q2 = yg * yg;
                    q2 += dpp_row_ror<8>(q2); q2 += dpp_row_ror<4>(q2); q2 += dpp_row_ror<2>(q2); q2 += dpp_row_ror<1>(q2);
                    sq[r] = q2;
                }
                if (l15 == 0) *(f32x4*)(part + pq * 64 + lb) = (f32x4){sq[0], sq[1], sq[2], sq[3]};
            }
            {
                const float dec = fecs[63];
#pragma unroll
                for (int nt = 0; nt < 8; nt++) {
                    f32x4 hh = Hacc[nt] * dec;
#pragma unroll
                    for (int ks = 0; ks < 2; ks++) {
                        const bf16x8 a = *(const bf16x8*)(BTs + (nt * 16 + l15) * S_LT + (((ks * 4 + quad) ^ ((nt * 2 + (l15 >> 3)) & 7)) * 8));
                        const bf16x8 bb = *(const bf16x8*)(XddT + (pq * 16 + l15) * S_LT + (((ks * 4 + quad) ^ ((pq * 2 + (l15 >> 3)) & 7)) * 8));
                        hh = __builtin_amdgcn_mfma_f32_16x16x32_bf16(a, bb, hh, 0, 0, 0);
                    }
                    Hacc[nt] = hh;
                }
            }
        }
        __syncthreads();
        if (tid < 64) ssq[((size_t)b * SEQ + 63 * 64 + tid) * 32 + head] = part[tid] + part[64 + tid] + part[128 + tid] + part[192 + tid];
        __syncthreads();
    }
}

__device__ __forceinline__ void ynorm_phase(bf16_t* ybuf, const float* __restrict__ ssq, const float* __restrict__ gate_norm, int bid, int nb, int wv) {
    const size_t nvec = (size_t)T * 2048 / 8; const int tid = opaque_tid(wv);
    for (size_t i = (size_t)bid * NTHREADS + tid; i < nvec; i += (size_t)nb * NTHREADS) {
        const size_t t = i >> 8; const int c = (int)(i & 255) * 8, g = c >> 8;
        const f32x4 s4 = *(const f32x4*)(ssq + t * 32 + g * 4);
        const float r = rsqrtf((s4[0] + s4[1] + s4[2] + s4[3]) * (1.f / 256.f) + 1e-5f);
        u32x4 v = *(u32x4*)(ybuf + t * 2048 + c);
        const float4 g0 = *(const float4*)(gate_norm + c), g1 = *(const float4*)(gate_norm + c + 4);
        v.x = pack2(bflo(v.x) * r * g0.x, bfhi(v.x) * r * g0.y); v.y = pack2(bflo(v.y) * r * g0.z, bfhi(v.y) * r * g0.w);
        v.z = pack2(bflo(v.z) * r * g1.x, bfhi(v.z) * r * g1.y); v.w = pack2(bflo(v.w) * r * g1.z, bfhi(v.w) * r * g1.w);
        *(u32x4*)(ybuf + t * 2048 + c) = v;
    }
}

__device__ __forceinline__ void rope_phase(bf16_t* qatt, bf16_t* kvbuf, const int* __restrict__ pos, int bid, int nb, int wv) {
    const int tid = opaque_tid(wv);
    pg8::StaticOrder SO; SO.init(T, 1280, nb, bid);
    pg8::Unit un;
    for (int ui = 0; SO.next(ui, un); ui++) {
        const int nh = un.pn == 0 ? 2 : 4, hb = un.pn == 0 ? 16 : 4 * (un.pn - 1);
        for (int i = tid; i < 256 * nh * 8; i += NTHREADS) {
            const int pr = i & 7, hd = hb + ((i >> 3) & (nh - 1)), t = un.pm * 256 + i / (8 * nh);
            const float inv = exp2f(-(float)pr * (18.931568569324174f / 8.f));
            const double rev = (double)pos[t] * (double)inv * 0.15915494309189535;
            const float fr = (float)(rev - floor(rev));
            const float sn = __builtin_amdgcn_sinf(fr), cs = __builtin_amdgcn_cosf(fr);
            bf16_t* ptr = hd < 16 ? qatt + (size_t)t * 1024 + hd * 64 : kvbuf + (size_t)t * 256 + (hd - 16) * 64;
            const float t1 = bf2f(ptr[pr]), t2 = bf2f(ptr[pr + 8]);
            ptr[pr] = f2bf(t1 * cs - t2 * sn); ptr[pr + 8] = f2bf(t2 * cs + t1 * sn);
        }
    }
}

constexpr int AT_KS = 72, AT_VS = 264;
__device__ __forceinline__ void attn_mfma(const bf16_t* __restrict__ qatt, const bf16_t* __restrict__ kvbuf, const float* __restrict__ sinks, bf16_t* __restrict__ aout, int bid, int nb, bf16_t* sm, int wv) {
    bf16_t* Ks = sm; bf16_t* Vt = sm + 256 * AT_KS;
    const int tid = opaque_tid(wv), lane = tid & 63, w = tid >> 6, l31 = lane & 31, half = lane >> 5;
    for (int item = bid; item < 512; item += nb) {
        const int g = item & 1, n = (item >> 1) & 31, b = item >> 6;
        const size_t tq0 = (size_t)b * SEQ + n * 128;
#pragma unroll
        for (int i = 0; i < 4; i++) {
            const int c = tid + 512 * i, kj = c >> 3, ch = c & 7;
            const bool ok = (n > 0) || (kj >= 128);
            const size_t tok = ok ? (tq0 - 128 + kj) : tq0;
            u32x4 kv = *(const u32x4*)(kvbuf + tok * 256 + g * 64 + ch * 8);
            u32x4 vv = *(const u32x4*)(kvbuf + tok * 256 + 128 + g * 64 + ch * 8);
            if (!ok) { kv = (u32x4){0u, 0u, 0u, 0u}; vv = kv; }
            *(u32x4*)(Ks + kj * AT_KS + ch * 8) = kv;
            const unsigned vw[4] = {vv.x, vv.y, vv.z, vv.w};
#pragma unroll
            for (int e = 0; e < 4; e++) { Vt[(ch * 8 + 2 * e) * AT_VS + kj] = (bf16_t)(vw[e] & 0xffffu); Vt[(ch * 8 + 2 * e + 1) * AT_VS + kj] = (bf16_t)(vw[e] >> 16); }
        }
        __syncthreads();
        const int hq = g * 8 + w;
        const float sink = sinks[hq];
#pragma unroll 1
        for (int qt = 0; qt < 4; qt++) {
            const bf16_t* qrow = qatt + (tq0 + qt * 32 + l31) * 1024 + hq * 64 + half * 8;
            bf16x8 qf[4];
#pragma unroll
            for (int ks = 0; ks < 4; ks++) qf[ks] = *(const bf16x8*)(qrow + ks * 16);
            f32x16 sacc[5];
#pragma unroll
            for (int kt = 0; kt < 5; kt++) {
#pragma unroll
                for (int r = 0; r < 16; r++) sacc[kt][r] = 0.f;
#pragma unroll
                for (int ks = 0; ks < 4; ks++) {
                    const bf16x8 a = *(const bf16x8*)(Ks + ((qt + kt) * 32 + l31) * AT_KS + ks * 16 + half * 8);
                    sacc[kt] = __builtin_amdgcn_mfma_f32_32x32x16_bf16(a, qf[ks], sacc[kt], 0, 0, 0);
                }
            }
            const int qi = qt * 32 + l31;
            float m = sink;
#pragma unroll
            for (int kt = 0; kt < 5; kt++)
#pragma unroll
                for (int r = 0; r < 16; r++) {
                    const int kj = (qt + kt) * 32 + (r & 3) + 8 * (r >> 2) + 4 * half;
                    const bool valid = kj > qi && kj <= qi + 128 && (n > 0 || kj >= 128);
                    sacc[kt][r] = valid ? sacc[kt][r] : -INFINITY;
                    m = fmaxf(m, sacc[kt][r]);
                }
            m = fmaxf(m, bperm(m, lane ^ 32));
            float sum = 0.f;
#pragma unroll
            for (int kt = 0; kt < 5; kt++)
#pragma unroll
                for (int r = 0; r < 16; r++) { const float p = __expf(sacc[kt][r] - m); sacc[kt][r] = p; sum += p; }
            sum += bperm(sum, lane ^ 32);
            sum += __expf(sink - m);
            f32x16 oacc[2];
#pragma unroll
            for (int dt = 0; dt < 2; dt++)
#pragma unroll
                for (int r = 0; r < 16; r++) oacc[dt][r] = 0.f;
#pragma unroll
            for (int kt = 0; kt < 5; kt++)
#pragma unroll
                for (int s2 = 0; s2 < 2; s2++) {
                    const u32x4 pk = (u32x4){pack2(sacc[kt][8 * s2 + 0], sacc[kt][8 * s2 + 1]), pack2(sacc[kt][8 * s2 + 2], sacc[kt][8 * s2 + 3]),
                                             pack2(sacc[kt][8 * s2 + 4], sacc[kt][8 * s2 + 5]), pack2(sacc[kt][8 * s2 + 6], sacc[kt][8 * s2 + 7])};
                    const bf16x8 pf = __builtin_bit_cast(bf16x8, pk);
#pragma unroll
                    for (int dt = 0; dt < 2; dt++) {
                        const bf16_t* vp = Vt + (dt * 32 + l31) * AT_VS + (qt + kt) * 32 + 16 * s2 + 4 * half;
                        const u32x2 v0 = *(const u32x2*)vp, v1 = *(const u32x2*)(vp + 8);
                        const bf16x8 a = __builtin_bit_cast(bf16x8, ((u32x4){v0.x, v0.y, v1.x, v1.y}));
                        oacc[dt] = __builtin_amdgcn_mfma_f32_32x32x16_bf16(a, pf, oacc[dt], 0, 0, 0);
                    }
                }
            const float inv = 1.f / sum;
            bf16_t* orow = aout + (tq0 + qt * 32 + l31) * 1024 + hq * 64 + 4 * half;
#pragma unroll
            for (int dt = 0; dt < 2; dt++)
#pragma unroll
                for (int r4 = 0; r4 < 4; r4++)
                    *(u32x2*)(orow + dt * 32 + 8 * r4) = (u32x2){pack2(oacc[dt][4 * r4] * inv, oacc[dt][4 * r4 + 1] * inv), pack2(oacc[dt][4 * r4 + 2] * inv, oacc[dt][4 * r4 + 3] * inv)};
        }
        __syncthreads();
    }
}

constexpr int RK_LDS = 136;
struct PairTab { unsigned char i[50], j[50]; };
constexpr PairTab make_pairs() { PairTab t{}; int p = 0; for (int i = 0; i < 16; i++) for (int j = 0; j < 16 / (i + 1); j++) { t.i[p] = (unsigned char)i; t.j[p] = (unsigned char)j; p++; } return t; }
constexpr PairTab PAIRS = make_pairs();
#define CE_DESC(a, b) do { const float hi_ = fmaxf(a, b), lo_ = fminf(a, b); a = hi_; b = lo_; } while (0)
#define CE_ASC(a, b)  do { const float hi_ = fmaxf(a, b), lo_ = fminf(a, b); a = lo_; b = hi_; } while (0)
template <int OFF> __device__ __forceinline__ void sort16_desc(float (&v)[64]) {
#pragma unroll
    for (int k = 2; k <= 16; k <<= 1)
#pragma unroll
        for (int j = k >> 1; j > 0; j >>= 1)
#pragma unroll
            for (int i = 0; i < 16; i++) {
                const int l = i ^ j;
                if (l > i) { if ((i & k) == 0) CE_DESC(v[OFF + i], v[OFF + l]); else CE_ASC(v[OFF + i], v[OFF + l]); }
            }
}
__device__ __forceinline__ void clean16_desc(float (&c)[16]) {
#pragma unroll
    for (int j = 8; j > 0; j >>= 1)
#pragma unroll
        for (int i = 0; i < 16; i++) { const int l = i ^ j; if (l > i) CE_DESC(c[i], c[l]); }
}
template <int A, int B> __device__ __forceinline__ void merge_top16(float (&v)[64]) {
    float c[16];
#pragma unroll
    for (int i = 0; i < 16; i++) c[i] = fmaxf(v[A + i], v[B + 15 - i]);
    clean16_desc(c);
#pragma unroll
    for (int i = 0; i < 16; i++) v[A + i] = c[i];
}
__device__ __forceinline__ void top16_of_64(float (&v)[64]) {
    sort16_desc<0>(v); sort16_desc<16>(v); sort16_desc<32>(v); sort16_desc<48>(v);
    merge_top16<0, 16>(v); merge_top16<32, 48>(v); merge_top16<0, 32>(v);
}
__device__ __forceinline__ void peer_route_mfma(const bf16_t* __restrict__ qbuf, const float* __restrict__ sk, int* __restrict__ idxb, float* __restrict__ gateb, int bid, int nb, bf16_t* sm, int wv) {
    const int tid = opaque_tid(wv), lane = tid & 63, w = tid >> 6, l31 = lane & 31, half = lane >> 5;
    for (int i = tid; i < 256 * 32; i += NTHREADS) {
        const int row = i >> 5, c4 = (i & 31) * 4;
        const float4 v = *(const float4*)(sk + (size_t)row * 128 + c4);
        *(u32x2*)(sm + row * RK_LDS + c4) = (u32x2){pack2(v.x, v.y), pack2(v.z, v.w)};
    }
    __syncthreads();
    pg8::StaticOrder SO; SO.init(T, 2048, nb, bid);
    pg8::Unit un;
    for (int ui = 0; SO.next(ui, un); ui++) {
        const int tg = un.pm * 8 + w, head = un.pn;
        const bf16_t* qrow = qbuf + (size_t)(tg * 32 + l31) * 2048 + head * 256 + half * 8;
        float tops[2][16];
#pragma unroll 1
        for (int c = 0; c < 2; c++) {
            f32x16 acc[4];
#pragma unroll
            for (int kt = 0; kt < 4; kt++)
#pragma unroll
                for (int r = 0; r < 16; r++) acc[kt][r] = 0.f;
            bf16x8 bq[8];
#pragma unroll
            for (int ks = 0; ks < 8; ks++) bq[ks] = *(const bf16x8*)(qrow + c * 128 + ks * 16);
#pragma unroll
            for (int ks = 0; ks < 8; ks++)
#pragma unroll
                for (int kt = 0; kt < 4; kt++) {
                    const bf16x8 a = *(const bf16x8*)(sm + (c * 128 + kt * 32 + l31) * RK_LDS + ks * 16 + half * 8);
                    acc[kt] = __builtin_amdgcn_mfma_f32_32x32x16_bf16(a, bq[ks], acc[kt], 0, 0, 0);
                }
            float v[64];
#pragma unroll
            for (int kt = 0; kt < 4; kt++)
#pragma unroll
                for (int r = 0; r < 16; r++) {
                    const unsigned key = (unsigned)(kt * 32 + (r & 3) + 8 * (r >> 2)) | ((unsigned)half << 2);
                    v[kt * 16 + r] = __uint_as_float((__float_as_uint(acc[kt][r]) & ~127u) | key);
                }
            float cur[16];
            top16_of_64(v);
            {
                float cm[16];
#pragma unroll
                for (int i = 0; i < 16; i++) cm[i] = fmaxf(v[i], bperm(v[15 - i], lane ^ 32));
                clean16_desc(cm);
#pragma unroll
                for (int i = 0; i < 16; i++) cur[i] = cm[i];
            }
            if (c == 0) {
#pragma unroll
                for (int rd = 0; rd < 16; rd++) tops[0][rd] = cur[rd];
            } else {
#pragma unroll
                for (int rd = 0; rd < 16; rd++) tops[1][rd] = cur[rd];
            }
        }
        float cand[64];
#pragma unroll
        for (int p = 0; p < 50; p++) {
            const float sum = tops[0][PAIRS.i[p]] + tops[1][PAIRS.j[p]];
            cand[p] = __uint_as_float((__float_as_uint(sum) & ~255u) | (unsigned)(PAIRS.i[p] * 16 + PAIRS.j[p]));
        }
#pragma unroll
        for (int p = 50; p < 64; p++) cand[p] = -INFINITY;
        top16_of_64(cand);
        float sel[16];
#pragma unroll
        for (int rd = 0; rd < 16; rd++) sel[rd] = cand[rd];
        unsigned k1[4], k2[4];
#pragma unroll
        for (int q4 = 0; q4 < 4; q4++) {
            k1[q4] = 0u; k2[q4] = 0u;
#pragma unroll
            for (int b = 0; b < 4; b++) {
                k1[q4] |= (__float_as_uint(tops[0][q4 * 4 + b]) & 127u) << (8 * b);
                k2[q4] |= (__float_as_uint(tops[1][q4 * 4 + b]) & 127u) << (8 * b);
            }
        }
        float ex[16]; float ssum = 0.f;
#pragma unroll
        for (int k = 0; k < 16; k++) { ex[k] = __expf(sel[k] - sel[0]); ssum += ex[k]; }
        const float inv = 1.f / ssum;
        unsigned outw[16];
#pragma unroll
        for (int k = 0; k < 16; k++) {
            const unsigned bits = __float_as_uint(sel[k]) & 255u, ii = bits >> 4, jj = bits & 15u;
            const unsigned d1 = (ii >> 2) == 0 ? k1[0] : (ii >> 2) == 1 ? k1[1] : (ii >> 2) == 2 ? k1[2] : k1[3];
            const unsigned d2 = (jj >> 2) == 0 ? k2[0] : (jj >> 2) == 1 ? k2[1] : (jj >> 2) == 2 ? k2[2] : k2[3];
            const unsigned e1 = (d1 >> (8 * (ii & 3))) & 127u, e2 = (d2 >> (8 * (jj & 3))) & 127u;
            const unsigned idx = e1 * 128u + e2;
            outw[k] = half == 0 ? idx : __float_as_uint(ex[k] * inv);
        }
        unsigned* dst = (half == 0 ? (unsigned*)idxb : (unsigned*)gateb) + ((size_t)(tg * 32 + l31) * 8 + head) * 16;
#pragma unroll
        for (int q4 = 0; q4 < 4; q4++) *(u32x4*)(dst + q4 * 4) = (u32x4){outw[q4 * 4], outw[q4 * 4 + 1], outw[q4 * 4 + 2], outw[q4 * 4 + 3]};
    }
    __syncthreads();
}

typedef unsigned u32x6 __attribute__((ext_vector_type(6)));
typedef float f32x32 __attribute__((ext_vector_type(32)));
struct Row6 { u32x4 a; u32x2 b; };
__device__ __forceinline__ Row6 ld6(const unsigned char* __restrict__ tab, int ie, int hl) {
    Row6 r; const unsigned char* p = tab + (size_t)ie * ROWB;
    r.a = *(const u32x4*)(p + hl * 16); r.b = *(const u32x2*)(p + 512 + hl * 8); return r;
}
__device__ __forceinline__ f32x32 dec6(const Row6& r) {
    const u32x6 sv = {r.a.x, r.a.y, r.a.z, r.a.w, r.b.x, r.b.y};
    return __builtin_amdgcn_cvt_scalef32_pk32_f32_fp6(sv, 1.0f);
}
typedef __bf16 hw_bf16x32 __attribute__((ext_vector_type(32)));
__device__ __forceinline__ float dot32_fp6(const Row6& r, const unsigned (&hp)[16]) {
    const u32x6 sv = {r.a.x, r.a.y, r.a.z, r.a.w, r.b.x, r.b.y};
    const hw_bf16x32 d = __builtin_amdgcn_cvt_scalef32_pk32_bf16_fp6(sv, 1.0f);
    float p0 = 0.f, p1 = 0.f;
#pragma unroll
    for (int k = 0; k < 8; k++) {
        const hw_bf16x2 a0 = {d[4 * k], d[4 * k + 1]}, a1 = {d[4 * k + 2], d[4 * k + 3]};
        p0 = __builtin_amdgcn_fdot2_f32_bf16(a0, __builtin_bit_cast(hw_bf16x2, hp[2 * k]), p0, false);
        p1 = __builtin_amdgcn_fdot2_f32_bf16(a1, __builtin_bit_cast(hw_bf16x2, hp[2 * k + 1]), p1, false);
    }
    return p0 + p1;
}
__device__ __forceinline__ int sel_half_i(int v, int s, int hh) { const int a = __builtin_amdgcn_readlane(v, 2 * s), b = __builtin_amdgcn_readlane(v, 2 * s + 1); return hh ? b : a; }
__device__ __forceinline__ float sel_half_f(float v, int s, int hh) { const float a = rl_f(v, 2 * s), b = rl_f(v, 2 * s + 1); return hh ? b : a; }
__device__ __forceinline__ void peer_u(const bf16_t* __restrict__ xb_in, const float* __restrict__ ssq_in, const unsigned char* __restrict__ u6,
                            const float* __restrict__ su, const float* __restrict__ sv, const int* __restrict__ idxb, float* __restrict__ gateb, int bid, int nb, float* sm, int wv) {
    const int tid = opaque_tid(wv), w = tid >> 6, lane = tid & 63, hl = lane & 31, hh = lane >> 5;
    float* scr = sm + w * (32 * 66);
    const int tstride = nb * NW, t0 = bid * NW + w;
    const int nh = 2 * ((T + tstride - 1) / tstride);
#define UTOK(g_) min(t0 + ((g_) >> 1) * tstride, T - 1)
#define UMETA_OFF(g_) ((size_t)UTOK(g_) * 128 + ((g_) & 1) * 64 + lane)
    int idx_c = idxb[UMETA_OFF(0)], idx_n = idxb[UMETA_OFF(1)], idx_nn = idx_n;
    unsigned hp[16], hq[16];
#pragma unroll
    for (int q4 = 0; q4 < 4; q4++) {
        const u32x4 a = *(const u32x4*)(xb_in + (size_t)UTOK(0) * DM + hl * 32 + q4 * 8);
        hp[q4 * 4 + 0] = a.x; hp[q4 * 4 + 1] = a.y; hp[q4 * 4 + 2] = a.z; hp[q4 * 4 + 3] = a.w;
        hq[q4 * 4 + 0] = a.x; hq[q4 * 4 + 1] = a.y; hq[q4 * 4 + 2] = a.z; hq[q4 * 4 + 3] = a.w;
    }
    Row6 qa[4], qb[4];
#pragma unroll
    for (int j = 0; j < 4; j++) qa[j] = ld6(u6, sel_half_i(idx_c, j, hh), hl);
#pragma unroll
    for (int j = 0; j < 4; j++) qb[j] = ld6(u6, sel_half_i(idx_c, 4 + j, hh), hl);
#pragma unroll
    for (int j = 0; j < 4; j++) asm volatile("" : "+v"(qa[j].a), "+v"(qa[j].b), "+v"(qb[j].a), "+v"(qb[j].b));
#pragma unroll
    for (int j = 0; j < 16; j += 4) asm volatile("" : "+v"(hp[j]), "+v"(hp[j + 1]), "+v"(hp[j + 2]), "+v"(hp[j + 3]));
    asm volatile("" : "+v"(idx_c), "+v"(idx_n));
#pragma unroll 1
    for (int g = 0; g < nh; g++) {
        const int t = UTOK(g);
        const bool active = t0 + (g >> 1) * tstride < T;
        idx_nn = idxb[UMETA_OFF(min(g + 2, nh - 1))];
        const float my_gate = gateb[(size_t)t * 128 + (g & 1) * 64 + lane];
        const float my_su = su[idx_c], my_sv = sv[idx_c];
        {
            const int tn = UTOK(min(g + 1, nh - 1));
#pragma unroll
            for (int q4 = 0; q4 < 4; q4++) {
                const u32x4 a = *(const u32x4*)(xb_in + (size_t)tn * DM + hl * 32 + q4 * 8);
                hq[q4 * 4 + 0] = a.x; hq[q4 * 4 + 1] = a.y; hq[q4 * 4 + 2] = a.z; hq[q4 * 4 + 3] = a.w;
            }
        }
        const float my_ssq = ssq_in[(size_t)t * 16 + (lane & 15)];
#pragma unroll
        for (int bb = 0; bb < 4; bb++) {
#pragma unroll
            for (int j = 0; j < 4; j++) scr[(8 * bb + j) * 66 + hh * 33 + hl] = dot32_fp6(qa[j], hp);
#pragma unroll
            for (int j = 0; j < 4; j++) qa[j] = ld6(u6, sel_half_i(bb < 3 ? idx_c : idx_n, (8 * bb + 8 + j) & 31, hh), hl);
            __builtin_amdgcn_sched_barrier(0);
#pragma unroll
            for (int j = 0; j < 4; j++) scr[(8 * bb + 4 + j) * 66 + hh * 33 + hl] = dot32_fp6(qb[j], hp);
#pragma unroll
            for (int j = 0; j < 4; j++) qb[j] = ld6(u6, sel_half_i(bb < 3 ? idx_c : idx_n, (8 * bb + 12 + j) & 31, hh), hl);
            __builtin_amdgcn_sched_barrier(0);
        }
        asm volatile("s_waitcnt lgkmcnt(0)" ::: "memory");
        float a = 0.f;
#pragma unroll 16
        for (int l = 0; l < 32; l++) a += scr[lane * 33 + l];
        asm volatile("s_waitcnt lgkmcnt(0)" ::: "memory");
        const float rs = rsqrtf(wave_sum(my_ssq) * (0.25f / DM) + 1e-6f);
        a *= my_su * rs;
        const float wgt = my_gate * my_sv * 0.5f * a * (1.f + erff(a * 0.70710678118f));
        if (active) gateb[(size_t)t * 128 + (g & 1) * 64 + lane] = wgt;
        idx_c = idx_n; idx_n = idx_nn;
#pragma unroll
        for (int j = 0; j < 16; j++) hp[j] = hq[j];
    }
    __syncthreads();
}
__device__ __forceinline__ void peer_v(const unsigned char* __restrict__ v6, const int* __restrict__ idxb, const float* __restrict__ wgtb,
                            const bf16_t* __restrict__ xb_in, bf16_t* __restrict__ xb_out, float* __restrict__ ssq_out, int bid, int nb, int wv) {
    const int tid = opaque_tid(wv), w = tid >> 6, lane = tid & 63, hl = lane & 31, hh = lane >> 5;
    const int tstride = nb * NW, t0 = bid * NW + w;
    if (t0 >= T) return;
    const int nh = 2 * ((T - 1 - t0) / tstride + 1);
#define VMETA_OFF(g_) ((size_t)(t0 + ((g_) >> 1) * tstride) * 128 + ((g_) & 1) * 64 + lane)
    int idx_c = idxb[VMETA_OFF(0)]; float wgt_c = wgtb[VMETA_OFF(0)];
    int idx_n = idxb[VMETA_OFF(1)]; float wgt_n = wgtb[VMETA_OFF(1)];
    Row6 qa[4], qb[4];
#pragma unroll
    for (int j = 0; j < 4; j++) qa[j] = ld6(v6, sel_half_i(idx_c, j, hh), hl);
#pragma unroll
    for (int j = 0; j < 4; j++) qb[j] = ld6(v6, sel_half_i(idx_c, 4 + j, hh), hl);
    f32x32 acc;
#pragma unroll
    for (int j = 0; j < 32; j++) acc[j] = 0.f;
    int idx_nn = idx_n; float wgt_nn = wgt_n;
    u32x4 xa = (u32x4){0u, 0u, 0u, 0u}, xc = xa;
#pragma unroll
    for (int j = 0; j < 4; j++) asm volatile("" : "+v"(qa[j].a), "+v"(qa[j].b), "+v"(qb[j].a), "+v"(qb[j].b));
    asm volatile("" : "+v"(idx_c), "+v"(wgt_c), "+v"(idx_n), "+v"(wgt_n));
#pragma unroll 1
    for (int g = 0; g < nh; g++) {
        const int t = t0 + (g >> 1) * tstride;
        { const int g2 = min(g + 2, nh - 1); idx_nn = idxb[VMETA_OFF(g2)]; wgt_nn = wgtb[VMETA_OFF(g2)]; }
        if (g & 1) { const bf16_t* xi = xb_in + (size_t)t * DM + hl * 32 + hh * 16; xa = *(const u32x4*)xi; xc = *(const u32x4*)(xi + 8); }
#pragma unroll
        for (int bb = 0; bb < 4; bb++) {
#pragma unroll
            for (int j = 0; j < 4; j++) {
                const float we = sel_half_f(wgt_c, 8 * bb + j, hh);
                const f32x32 d = dec6(qa[j]);
                acc += d * we;
                if (j < 3) asm volatile("" : "+v"(acc), "+v"(qa[j + 1].a)); else asm volatile("" : "+v"(acc));
            }
#pragma unroll
            for (int j = 0; j < 4; j++) qa[j] = ld6(v6, sel_half_i(bb < 3 ? idx_c : idx_n, (8 * bb + 8 + j) & 31, hh), hl);
            __builtin_amdgcn_sched_barrier(0);
#pragma unroll
            for (int j = 0; j < 4; j++) {
                const float we = sel_half_f(wgt_c, 8 * bb + 4 + j, hh);
                const f32x32 d = dec6(qb[j]);
                acc += d * we;
                if (j < 3) asm volatile("" : "+v"(acc), "+v"(qb[j + 1].a)); else asm volatile("" : "+v"(acc));
            }
#pragma unroll
            for (int j = 0; j < 4; j++) qb[j] = ld6(v6, sel_half_i(bb < 3 ? idx_c : idx_n, (8 * bb + 12 + j) & 31, hh), hl);
            __builtin_amdgcn_sched_barrier(0);
        }
        idx_c = idx_n; wgt_c = wgt_n; idx_n = idx_nn; wgt_n = wgt_nn;
        if (g & 1) {
            float mine[16];
#pragma unroll
            for (int k = 0; k < 16; k++) {
                const float lo = acc[k] + bperm(acc[k], lane ^ 32), hi = acc[16 + k] + bperm(acc[16 + k], lane ^ 32);
                mine[k] = hh ? hi : lo;
            }
#pragma unroll
            for (int j = 0; j < 32; j++) acc[j] = 0.f;
            const float xin[16] = {bflo(xa.x), bfhi(xa.x), bflo(xa.y), bfhi(xa.y), bflo(xa.z), bfhi(xa.z), bflo(xa.w), bfhi(xa.w),
                                   bflo(xc.x), bfhi(xc.x), bflo(xc.y), bfhi(xc.y), bflo(xc.z), bfhi(xc.z), bflo(xc.w), bfhi(xc.w)};
            float sq = 0.f; unsigned pk[8];
#pragma unroll
            for (int q4 = 0; q4 < 4; q4++) {
                const f32x4 x = (f32x4){xin[q4 * 4] + mine[q4 * 4], xin[q4 * 4 + 1] + mine[q4 * 4 + 1], xin[q4 * 4 + 2] + mine[q4 * 4 + 2], xin[q4 * 4 + 3] + mine[q4 * 4 + 3]};
                sq += (x[0] * x[0] + x[1] * x[1]) + (x[2] * x[2] + x[3] * x[3]);
                pk[2 * q4] = pack2(x[0], x[1]); pk[2 * q4 + 1] = pack2(x[2], x[3]);
            }
            sq = wave_sum(sq);
            bf16_t* xo = xb_out + (size_t)t * DM + hl * 32 + hh * 16;
            *(u32x4*)xo = (u32x4){pk[0], pk[1], pk[2], pk[3]};
            *(u32x4*)(xo + 8) = (u32x4){pk[4], pk[5], pk[6], pk[7]};
            if (lane < 16) ssq_out[(size_t)t * 16 + lane] = lane == 0 ? sq : 0.f;
        }
    }
}

__device__ const int TJ_IN[11]      = {4, 11, 22, 22, 13, 16, 19, 28, 28, 27, 27};
__device__ const int TJ_SRCOFF[11]  = {0, 0, 0, 1024 * 2048, 0, 0, 0, 0, 1024 * 1024, 0, 256 * 1024};
__device__ const int TJ_GIN[11]     = {3, 10, 21, 21, 12, 15, -1, 26, 26, -1, -1};
__device__ const int TJ_GOFF[11]    = {0, 0, 0, 1024, 0, 0, 0, 0, 1024, 0, 0};
__device__ const int TJ_CUM[12]     = {0, 1600, 2112, 2624, 3136, 3200, 3456, 3712, 3968, 4224, 4288, 4352};
__device__ const int TJ_K[11]       = {1024, 2048, 1024, 1024, 1024, 1024, 1024, 1024, 1024, 256, 256};
__device__ const int TJ_N[11]       = {6176, 1024, 2048, 2048, 256, 1024, 1024, 1024, 1024, 1024, 1024};
__device__ const int TJ_NPAD[11]    = {6400, 1024, 2048, 2048, 256, 1024, 1024, 1024, 1024, 1024, 1024};
__device__ const unsigned TJ_DST[11] = {(unsigned)OFF_W_IN, (unsigned)OFF_W_OUT, (unsigned)OFF_W_PQ, (unsigned)(OFF_W_PQ + 2048 * 1024 * 2), (unsigned)OFF_W_KV, (unsigned)OFF_W_Q, (unsigned)OFF_W_O,
                                        (unsigned)OFF_W_PG, (unsigned)(OFF_W_PG + 1024 * 1024 * 2), (unsigned)OFF_W_PP, (unsigned)(OFF_W_PP + 1024 * 256 * 2)};
constexpr int NPHASES = 22;
constexpr int SMEM_BYTES = 131072 + 8192;
static_assert(SMEM_BYTES >= pg8::STAGE_BYTES + 8192 && SMEM_BYTES >= 12352 * 4 && SMEM_BYTES >= 256 * RK_LDS * 2 && SMEM_BYTES >= SSD_SMEM && SMEM_BYTES <= 160 * 1024, "smem");

template <int ph> __device__ __forceinline__ void run_phase(const Params& P, int bid, int nb, unsigned char* smem, int wv) {
    unsigned char* ws = P.ws;
    float* smf = (float*)smem; bf16_t* smb = (bf16_t*)smem;
    bf16_t* W_IN = (bf16_t*)(ws + OFF_W_IN); bf16_t* W_OUT = (bf16_t*)(ws + OFF_W_OUT); bf16_t* W_PQ = (bf16_t*)(ws + OFF_W_PQ);
    bf16_t* W_KV = (bf16_t*)(ws + OFF_W_KV); bf16_t* W_Q = (bf16_t*)(ws + OFF_W_Q); bf16_t* W_O = (bf16_t*)(ws + OFF_W_O);
    bf16_t* W_PG = (bf16_t*)(ws + OFF_W_PG); bf16_t* W_PP = (bf16_t*)(ws + OFF_W_PP);
    bf16_t* zx = (bf16_t*)(ws + OFF_Z); float* dtraw = (float*)(ws + OFF_DT); float* ssq = (float*)(ws + OFF_SSQ);
    unsigned char* u8 = ws + OFF_U; unsigned char* v8 = ws + OFF_U + 32 * MiB; float* su = (float*)(ws + OFF_SCL); float* sv = su + 2 * 16384; bf16_t* p_bf = (bf16_t*)(ws + OFF_P);
    bf16_t* xbA = (bf16_t*)(ws + OFF_H); bf16_t* xbB = (bf16_t*)(ws + OFF_V);
    float* ssq0 = (float*)(ws + OFF_SSQP); float* ssq1 = ssq0 + (size_t)T * 16;
    int* idxb = (int*)(ws + OFF_IDX); float* gateb = (float*)(ws + OFF_GATE);
    bf16_t* kvbuf = (bf16_t*)(ws + OFF_KV); bf16_t* aout = (bf16_t*)(ws + OFF_AO);
    bf16_t* obuf = (bf16_t*)P.out;
    int zoff; asm volatile("s_mov_b32 %0, 0" : "=s"(zoff));
    const float* const* in = P.in + zoff;
    switch (ph) {
    case 0:
#pragma unroll 1
        for (int gt = bid; gt < 1600; gt += nb)
            transpose_convert(in[TJ_IN[0]], in[TJ_GIN[0]], TJ_K[0], TJ_N[0], TJ_NPAD[0], (bf16_t*)(ws + TJ_DST[0]), gt, nb, smf, wv);
        convert_x_rows(in[0], obuf, ssq0, bid, nb, wv);
        break;
    case 1: {
        auto tr_rest = [&]() {
#pragma unroll 1
            for (int gt = 1600 + bid; gt < 4352; gt += nb) {
                int j = 1;
#pragma unroll 1
                while (gt >= TJ_CUM[j + 1]) j++;
                const float* src = in[TJ_IN[j]] + TJ_SRCOFF[j];
                const int gi = TJ_GIN[j];
                const float* gain = gi >= 0 ? in[gi] + TJ_GOFF[j] : nullptr;
                transpose_convert(src, gain, TJ_K[j], TJ_N[j], TJ_NPAD[j], (bf16_t*)(ws + TJ_DST[j]), gt - TJ_CUM[j], nb, smf, wv);
            }
        };
        if (bid & 1) tr_rest();
        gemm_phase(obuf, 1024, W_IN, 1024, T, 6144, 1024, EpiInProj{&P, PR_WS(OFF_Z), PR_WS(OFF_DT), PR_WS(OFF_SSQP)}, bid, nb, smb, wv);
        if (!(bid & 1)) tr_rest();
        break; }
    case 2: ssd_chunked(zx, dtraw, in[5], in[6], in[7], in[8], in[9], obuf, ssq, bid, nb, smem, wv); break;
    case 3: break;
    case 4: {
        auto conv = [&]() {
            convert_fp6_rows(in[24], in[21], u8, su, 2 * 16384, bid, nb, wv);
            convert_fp6_rows(in[25], nullptr, v8, sv, 2 * 16384, bid, nb, wv);
            convert_flat(in[1], p_bf, (size_t)2 * T * 256, bid, nb, wv);
        };
        if (bid & 1) conv();
        gemm_phase(obuf, 2048, W_OUT, 2048, T, 1024, 2048, EpiResidY{{&P, PR_IN(0, 0), PR_NUL, PR_NUL, PR_WS(OFF_V), PR_WS(OFF_SSQP + (size_t)T * 16 * 4)}, PR_WS(OFF_SSQ)}, bid, nb, smb, wv);
        if (!(bid & 1)) conv();
        break; }
    case 5: gemm_phase(xbB, 1024, W_PQ, 1024, T, 2048, 1024, EpiBf16{&P, PR_OUT(0), 2048, PR_NUL, 1.f, PR_WS(OFF_SSQP + (size_t)T * 16 * 4)}, bid, nb, smb, wv); break;
    case 6: peer_route_mfma(obuf, in[23], idxb, gateb, bid, nb, smb, wv); break;
    case 7: peer_u(xbB, ssq1, u8, su, sv, idxb, gateb, bid, nb, smf, wv); break;
    case 8: peer_v(v8, idxb, gateb, xbB, xbA, ssq0, bid, nb, wv); break;
    case 9: gemm_phase(p_bf, 256, W_PP, 256, T, 1024, 256, EpiBf16{&P, PR_OUT(0), 1024, PR_NUL, 1.f, PR_NUL}, bid, nb, smb, wv); break;
    case 10: gemm_phase(xbA, 1024, W_PG, 1024, T, 1024, 1024, EpiPle{&P, PR_WS(OFF_H), PR_OUT(0), PR_WS(OFF_SSQP), PR_WS(OFF_V), PR_WS(OFF_SSQP + (size_t)T * 16 * 4)}, bid, nb, smb, wv); break;
    case 11: gemm_phase(xbB, 1024, W_KV, 1024, T, 1280, 1024, EpiKVQ{&P, PR_WS(OFF_KV), PR_OUT(0), PR_IN(14, 0), PR_IN(17, 0), PR_WS(OFF_SSQP + (size_t)T * 16 * 4)}, bid, nb, smb, wv); break;
    case 12: rope_phase(obuf, kvbuf, (const int*)in[2], bid, nb, wv); break;
    case 13: attn_mfma(obuf, kvbuf, in[18], aout, bid, nb, smb, wv); break;
    case 14: gemm_phase(aout, 1024, W_O, 1024, T, 1024, 1024, EpiResid{&P, PR_NUL, PR_WS(OFF_V), PR_IN(20, 0), PR_WS(OFF_H), PR_WS(OFF_SSQP)}, bid, nb, smb, wv); break;
    case 15: gemm_phase(xbA, 1024, W_PQ + (size_t)2048 * 1024, 1024, T, 2048, 1024, EpiBf16{&P, PR_OUT(0), 2048, PR_NUL, 1.f, PR_WS(OFF_SSQP)}, bid, nb, smb, wv); break;
    case 16: peer_route_mfma(obuf, in[23] + 2 * 128 * 128, idxb, gateb, bid, nb, smb, wv); break;
    case 17: peer_u(xbA, ssq0, u8 + (size_t)16384 * ROWB, su + 16384, sv + 16384, idxb, gateb, bid, nb, smf, wv); break;
    case 18: peer_v(v8 + (size_t)16384 * ROWB, idxb, gateb, xbA, xbB, ssq1, bid, nb, wv); break;
    case 19: gemm_phase(p_bf + (size_t)T * 256, 256, W_PP + (size_t)1024 * 256, 256, T, 1024, 256, EpiBf16{&P, PR_OUT(0), 1024, PR_NUL, 1.f, PR_NUL}, bid, nb, smb, wv); break;
    case 20: gemm_phase(xbB, 1024, W_PG + (size_t)1024 * 1024, 1024, T, 1024, 1024, EpiPle{&P, PR_WS(OFF_V), PR_OUT(0), PR_WS(OFF_SSQP + (size_t)T * 16 * 4), PR_WS(OFF_H), PR_WS(OFF_SSQP)}, bid, nb, smb, wv); break;
    case 21: final_norm_rows(xbA, ssq0, in[29], P.out, bid, nb, wv); break;
    default: break;
    }
}

#define XB_TMO      128
#define XB_XCNT(j)  (256  + 64 * (j))
#define XB_XSUB(j)  (1280 + 64 * (j))
#define XB_XGEN(j)  (2304 + 64 * (j))
#define XB_TOP      3328
#define XB_TOPGEN   3392
#define XCD_BAR_WORDS 3456
#define XB_SPIN_CAP (1u << 18)
#define LAS __attribute__((address_space(3)))

__device__ __forceinline__ unsigned xb_ld(unsigned* p)              { return __hip_atomic_load(p, __ATOMIC_RELAXED, __HIP_MEMORY_SCOPE_AGENT); }
__device__ __forceinline__ unsigned xb_add(unsigned* p, unsigned v) { return __hip_atomic_fetch_add(p, v, __ATOMIC_RELAXED, __HIP_MEMORY_SCOPE_AGENT); }
__device__ __forceinline__ unsigned xb_xcc_id() { return (unsigned)__builtin_amdgcn_s_getreg((3 << 11) | 20) & 0xFu; }
#define XB_SPIN(cond, bar) do { unsigned _sp = 0; while (cond) { __builtin_amdgcn_s_sleep(1); \
    if ((++_sp & 255u) == 0u) { if (xb_ld(&(bar)[XB_TMO])) break; if (_sp > XB_SPIN_CAP) { atomicAdd(&(bar)[XB_TMO], 1u); break; } } } } while (0)

struct XcdBarrier {
    unsigned* bar; unsigned x;
    volatile LAS unsigned* st;
};

__device__ __forceinline__ XcdBarrier xcd_barrier_post(unsigned* bar, volatile LAS unsigned* st, bool t0) {
    XcdBarrier b; b.bar = bar; b.x = xb_xcc_id(); b.st = st;
    if (t0) (void)xb_add(&bar[XB_XCNT(b.x)], 1u);
    return b;
}
__device__ __forceinline__ void xcd_barrier_complete(unsigned* bar, unsigned x, unsigned& nloc, unsigned& nx) {
    const unsigned G = gridDim.x * gridDim.y * gridDim.z;
    unsigned sum, cnt, mine, sp = 0u;
    for (;;) {
        sum = 0u; cnt = 0u; mine = 0u;
#pragma unroll
        for (unsigned j = 0; j < 16; ++j) { const unsigned c = xb_ld(&bar[XB_XCNT(j)]); sum += c; cnt += (c > 0u) ? 1u : 0u; mine = (j == x) ? c : mine; }
        if (sum == G) break;
        __builtin_amdgcn_s_sleep(1);
        if ((++sp & 255u) == 0u) { if (xb_ld(&bar[XB_TMO])) break; if (sp > XB_SPIN_CAP) { atomicAdd(&bar[XB_TMO], 1u); break; } }
    }
    nloc = mine > 0u ? mine : 1u; nx = cnt > 0u ? cnt : 1u;
}

__device__ __forceinline__ void xcd_barrier(const XcdBarrier& b, bool t0) {
    asm volatile("s_waitcnt vmcnt(0)" ::: "memory");
    __syncthreads();
    if (t0) {
        unsigned* bar = b.bar;
        __builtin_amdgcn_s_waitcnt(0);
        unsigned nloc = b.st[0], nx = b.st[1];
        if (nloc == 0u) { xcd_barrier_complete(bar, b.x, nloc, nx); b.st[0] = nloc; b.st[1] = nx; }
        const unsigned old = xb_add(&bar[XB_XSUB(b.x)], 1u);
        const unsigned gen = old / nloc;
        if (old + 1u == (gen + 1u) * nloc) {
            __builtin_amdgcn_fence(__ATOMIC_RELEASE, "agent");
            asm volatile("s_waitcnt vmcnt(0)" ::: "memory");
            const unsigned og = xb_add(&bar[XB_TOP], 1u);
            const unsigned tg = og / nx;
            if (og + 1u == (tg + 1u) * nx) xb_add(&bar[XB_TOPGEN], 1u);
            else XB_SPIN(xb_ld(&bar[XB_TOPGEN]) == tg, bar);
            __builtin_amdgcn_fence(__ATOMIC_ACQUIRE, "agent");
            xb_add(&bar[XB_XGEN(b.x)], 1u);
            asm volatile("s_waitcnt vmcnt(0)" ::: "memory");
        } else {
            XB_SPIN(xb_ld(&bar[XB_XGEN(b.x)]) == gen, bar);
            __builtin_amdgcn_fence(__ATOMIC_ACQUIRE, "agent");
            asm volatile("s_waitcnt vmcnt(0)" ::: "memory");
        }
    }
    __syncthreads();
}


#ifdef PROBE_MASK_B
#define PROBE_BUILD 1
#else
#define PROBE_MASK_A 0ull
#define PROBE_MASK_B 0ull
#endif
constexpr bool PROBE = (PROBE_MASK_A | PROBE_MASK_B) != 0ull;
template <int ph> __device__ __forceinline__ void run_all(const Params& P, const XcdBarrier& xb, unsigned char* smem, int wv) {
    if constexpr (ph < NPHASES) {
        if constexpr (ph == 2) {
            bf16_t* zxp = (bf16_t*)(P.ws + opaque_zero() + OFF_Z);
            const BcHalo bh = bc_preact_halo(zxp, blockIdx.x, gridDim.x, wv);
            { unsigned char* wsp = P.ws + opaque_zero();
              dt_minigemm((const bf16_t*)((&P.out)[opaque_zero()]), (const bf16_t*)(wsp + OFF_W_IN) + (size_t)6144 * 1024, (const float*)(wsp + OFF_SSQP), (float*)(wsp + OFF_DT), blockIdx.x, gridDim.x, wv); }
            xcd_barrier(xb, opaque_tid(wv) == 0);
            { const float* const* inp = P.in + opaque_zero(); bc_preact_walk(zxp, inp[5], inp[6], bh, blockIdx.x, gridDim.x, wv); }
            xcd_barrier(xb, opaque_tid(wv) == 0);
        }
        run_phase<ph>(P, blockIdx.x, gridDim.x, smem, wv);
        if constexpr (ph == 5 || ph == 15 || ph == 11) __syncthreads();
        else if constexpr (ph + 1 < NPHASES && ph != 3 && ph != 7 && ph != 8 && ph != 17 && ph != 18) xcd_barrier(xb, opaque_tid(wv) == 0);
        run_all<ph + 1>(P, xb, smem, wv);
    }
}

__global__ void __launch_bounds__(NTHREADS, 2) fwd_megakernel(Params P) {
    __shared__ __attribute__((aligned(16))) unsigned char smem[SMEM_BYTES + 16];
    const int wv = __builtin_amdgcn_readfirstlane(threadIdx.x >> 6);
    if (blockIdx.x == 0) {
        unsigned* bar0 = (unsigned*)(P.ws + OFF_BAR);
        for (int i = threadIdx.x; i < XCD_BAR_WORDS; i += NTHREADS) __hip_atomic_store(&bar0[i], 0u, __ATOMIC_RELAXED, __HIP_MEMORY_SCOPE_AGENT);
        __threadfence();
    }
    cg::this_grid().sync();
    volatile LAS unsigned* xst = (volatile LAS unsigned*)(LAS unsigned char*)(smem + SMEM_BYTES);
    if (opaque_tid(wv) == 0) { xst[0] = 0u; xst[1] = 0u; }
    __syncthreads();
    const XcdBarrier xb = xcd_barrier_post((unsigned*)(P.ws + OFF_BAR), xst, opaque_tid(wv) == 0);
    run_all<0>(P, xb, smem, wv);
}

#ifdef PROBE_BUILD
template <int ph> __device__ __forceinline__ void run_sel(const Params& P, int sel, unsigned char* smem, int wv) {
    if constexpr (ph < NPHASES) { if (sel == ph) run_phase<ph>(P, blockIdx.x, gridDim.x, smem, wv); run_sel<ph + 1>(P, sel, smem, wv); }
}
__global__ void __launch_bounds__(NTHREADS, 2) k_sel(Params P, int sel) {
    __shared__ __attribute__((aligned(16))) unsigned char smem[SMEM_BYTES + 16];
    const int wv = __builtin_amdgcn_readfirstlane(threadIdx.x >> 6);
    if (blockIdx.x == 0 && threadIdx.x == 0) ((unsigned long long*)P.ws)[sel] = __builtin_amdgcn_s_memrealtime();
    if (sel == 100) { bf16_t* zxp = (bf16_t*)(P.ws + OFF_Z); const BcHalo bh = bc_preact_halo(zxp, blockIdx.x, gridDim.x, wv);
        dt_minigemm((const bf16_t*)P.out, (const bf16_t*)(P.ws + OFF_W_IN) + (size_t)6144 * 1024, (const float*)(P.ws + OFF_SSQP), (float*)(P.ws + OFF_DT), blockIdx.x, gridDim.x, wv); bc_preact_walk(zxp, P.in[5], P.in[6], bh, blockIdx.x, gridDim.x, wv); return; }
    run_sel<0>(P, sel, smem, wv);
}
static void launch_phases(const Params& P, int grid, hipStream_t stream) {
    for (int sel = 0; sel < NPHASES; sel++) {
        if (sel == 2) hipLaunchKernelGGL(k_sel, dim3(grid), dim3(NTHREADS), 0, stream, P, 100);
        hipLaunchKernelGGL(k_sel, dim3(grid), dim3(NTHREADS), 0, stream, P, sel);
    }
}
__global__ void __launch_bounds__(256) probe_post(Params P) {
    unsigned long long* ts = (unsigned long long*)P.ws;
    if (blockIdx.x == 0 && threadIdx.x == 0) { ts[NPHASES] = __builtin_amdgcn_s_memrealtime(); __threadfence(); }
    __syncthreads();
    if (blockIdx.x != 0) return;
    const float total = (float)(ts[NPHASES] - ts[0]); float b = 0.f;
    for (int k = 0; k < NPHASES; k++) { const float d = (float)(ts[k + 1] - ts[k]); if ((PROBE_MASK_B >> k) & 1ull) b += d; }
    const float VB = 100.f * b / total;
    for (size_t i = threadIdx.x; i < (size_t)2048 * 1024; i += 256) {
        float v = P.out[i] + 0.5f; if (i == 0) v += VB + 8.f; P.out[i] = v;
    }
}

#endif

extern "C" void kernel_launch(void* const* d_in, const int* in_sizes, int n_in, void* d_out, int out_size, void* d_ws, size_t ws_size, hipStream_t stream) {
    if (n_in != 30 || ws_size < WS_END) { fprintf(stderr, "kernel_launch: unexpected n_in %d / ws_size %zu (need %zu)\n", n_in, ws_size, (size_t)WS_END); return; }
    static int grid_blocks = 0;
    if (!grid_blocks) {
        int dev = 0, cus = 0, per_cu = 0;
        hipGetDevice(&dev);
        hipDeviceGetAttribute(&cus, hipDeviceAttributeMultiprocessorCount, dev);
        hipOccupancyMaxActiveBlocksPerMultiprocessor(&per_cu, fwd_megakernel, NTHREADS, 0);
        if (per_cu > 1) per_cu = 1;
        if (per_cu < 1) per_cu = 1;
        grid_blocks = cus * per_cu;
        fprintf(stderr, "kernel_launch: cus %d per_cu %d grid %d\n", cus, per_cu, grid_blocks);
    }
    Params P{};
    for (int i = 0; i < 30; i++) P.in[i] = (const float*)d_in[i];
    P.out = (float*)d_out; P.ws = (unsigned char*)d_ws;
#ifdef PROBE_BUILD
    launch_phases(P, grid_blocks, stream); hipLaunchKernelGGL(probe_post, dim3(1), dim3(256), 0, stream, P); return;
#endif
    void* args[] = {&P};
    hipError_t e = hipLaunchCooperativeKernel((void*)fwd_megakernel, dim3(grid_blocks), dim3(NTHREADS), args, 0, stream);
    if (e != hipSuccess) fprintf(stderr, "cooperative launch failed: %s (grid %d)\n", hipGetErrorString(e), grid_blocks);
}
```
